# Optimizing an MI355X kernel written in HIP

```python
import math
import jax
import jax.numpy as jnp
from jax import lax
import numpy as np

D_MODEL = 2048
BATCH = 4
SEQ = 2048
DEPTH = 2
DEC_BATCH = 8
DEC_SEQ = 64
PAST_LEN = 4096

CHUNK = 64
N_MIXERS = 2
N_RET = (DEPTH + 1) // 2
N_SSD = DEPTH // 2

RET_HEADS = 8
RET_DK = D_MODEL // RET_HEADS
RET_DV = 2 * RET_DK
RET_QK_DIM = RET_HEADS * RET_DK
RET_V_DIM = RET_HEADS * RET_DV
RET_IN = 2 * RET_QK_DIM + 2 * RET_V_DIM
ROPE_BASE = 10000.0

SSD_D_INNER = 2 * D_MODEL
SSD_HEADDIM = 64
SSD_HEADS = SSD_D_INNER // SSD_HEADDIM
SSD_GROUPS = 8
SSD_HPG = SSD_HEADS // SSD_GROUPS
SSD_DSTATE = 128
CONV_W = 4
CONV_DIM = SSD_D_INNER + 2 * SSD_GROUPS * SSD_DSTATE
SSD_IN = SSD_D_INNER + CONV_DIM + SSD_HEADS

D_FF = -(-8 * D_MODEL // (3 * 256)) * 256

EPS = 1e-6

kernel_name = "retnet_mamba2_streaming_step"


def _rms(xf):
    return xf * lax.rsqrt(jnp.mean(xf * xf, axis=-1, keepdims=True) + EPS)


def rmsnorm(x, w):
    y = _rms(x.astype(jnp.float32)) * w.astype(jnp.float32)
    return y.astype(x.dtype)


def rotary(x, pos):
    half = x.shape[-1] // 2
    inv = ROPE_BASE ** (-jnp.arange(half, dtype=jnp.float32) / half)
    ang = pos.astype(jnp.float32)[:, None] * inv[None, :]
    cos = jnp.cos(ang)[None, :, None, :]
    sin = jnp.sin(ang)[None, :, None, :]
    x1, x2 = x[..., :half], x[..., half:]
    return jnp.concatenate([x1 * cos - x2 * sin, x2 * cos + x1 * sin], axis=-1)


def retention_mixer(h, pos, s0, w_in, w_out):
    f32 = jnp.float32
    b, L, _ = h.shape
    T = min(CHUNK, L)
    nc = L // T
    proj = h @ w_in
    q, k, v, g = jnp.split(proj, [RET_QK_DIM, 2 * RET_QK_DIM, 2 * RET_QK_DIM + RET_V_DIM], axis=-1)
    q = rotary(q.reshape(b, L, RET_HEADS, RET_DK).astype(f32), pos)
    k = rotary(k.reshape(b, L, RET_HEADS, RET_DK).astype(f32), pos) * (RET_DK ** -0.5)
    v = v.reshape(b, L, RET_HEADS, RET_DV).astype(f32)
    log_g = jnp.log1p(-jnp.exp2(-5.0 - jnp.arange(RET_HEADS, dtype=f32)))
    idx = jnp.arange(T, dtype=f32)
    dist = jnp.abs(idx[:, None] - idx[None, :])
    intra_dec = jnp.exp(log_g[:, None, None] * dist)
    q_dec = jnp.exp((idx[:, None] + 1.0) * log_g[None, :])
    k_dec = jnp.exp((T - 1.0 - idx)[:, None] * log_g[None, :])
    c_dec = jnp.exp(T * log_g)
    qc = q.reshape(b, nc, T, RET_HEADS, RET_DK)
    kc = k.reshape(b, nc, T, RET_HEADS, RET_DK)
    vc = v.reshape(b, nc, T, RET_HEADS, RET_DV)
    scores = jnp.einsum("bcihd,bcjhd->bchij", qc, kc) * intra_dec
    y_intra = jnp.einsum("bchij,bcjhe->bcihe", scores, vc)

    def step(S, blk):
        qi, ki, vi = blk
        y_cross = jnp.einsum("bihd,bhde->bihe", qi * q_dec[None, :, :, None], S)
        S = S * c_dec[None, :, None, None] + jnp.einsum(
            "bjhd,bjhe->bhde", ki * k_dec[None, :, :, None], vi)
        return S, y_cross

    s_fin, y_cross = lax.scan(
        step, s0.astype(f32), (qc.swapaxes(0, 1), kc.swapaxes(0, 1), vc.swapaxes(0, 1)))
    y = (y_intra + y_cross.swapaxes(0, 1)).reshape(b, L, RET_HEADS, RET_DV)
    y = _rms(y).reshape(b, L, RET_V_DIM)
    out = (jax.nn.silu(g.astype(f32)) * y).astype(h.dtype) @ w_out
    return out, s_fin.astype(h.dtype)


def ssd_mixer(h, conv0, s0, w_in, conv_w, conv_b, dt_bias, a_log, d_skip, norm_w, w_out):
    f32 = jnp.float32
    b, L, _ = h.shape
    T = min(CHUNK, L)
    nc = L // T
    G, R, P, N = SSD_GROUPS, SSD_HPG, SSD_HEADDIM, SSD_DSTATE
    proj = h @ w_in
    z, xbc, dt = jnp.split(proj, [SSD_D_INNER, SSD_D_INNER + CONV_DIM], axis=-1)
    xpad = jnp.concatenate([conv0.astype(xbc.dtype), xbc], axis=1)
    new_conv = xpad[:, L:]
    xc = conv_b + sum(xpad[:, t:t + L] * conv_w[t] for t in range(CONV_W))
    xc = jax.nn.silu(xc.astype(f32))
    xs, Bm, Cm = jnp.split(xc, [SSD_D_INNER, SSD_D_INNER + G * N], axis=-1)
    x = xs.reshape(b, nc, T, G, R, P)
    Bm = Bm.reshape(b, nc, T, G, N)
    Cm = Cm.reshape(b, nc, T, G, N)
    dt = jax.nn.softplus(dt.astype(f32) + dt_bias.astype(f32))
    A = -jnp.exp(a_log.astype(f32))
    cum = jnp.cumsum((dt * A).reshape(b, nc, T, G, R), axis=2)
    xdt = x * dt.reshape(b, nc, T, G, R)[..., None]
    causal = jnp.tril(jnp.ones((T, T), dtype=bool))[:, :, None, None]
    seg = cum[:, :, :, None] - cum[:, :, None, :]
    Lmat = jnp.exp(jnp.where(causal, seg, -jnp.inf))
    cb = jnp.einsum("bcign,bcjgn->bcijg", Cm, Bm)
    y_intra = jnp.einsum("bcijgr,bcjgrp->bcigrp", cb[..., None] * Lmat, xdt)

    def step(S, blk):
        Ci, Bi, xdti, cumi = blk
        y_cross = jnp.einsum("bign,bgrpn->bigrp", Ci, S) * jnp.exp(cumi)[..., None]
        dec_end = jnp.exp(cumi[:, -1:] - cumi)
        S = S * jnp.exp(cumi[:, -1])[..., None, None] + jnp.einsum(
            "bjgn,bjgrp->bgrpn", Bi, xdti * dec_end[..., None])
        return S, y_cross

    s_fin, y_cross = lax.scan(
        step, s0.astype(f32).reshape(b, G, R, P, N),
        (Cm.swapaxes(0, 1), Bm.swapaxes(0, 1), xdt.swapaxes(0, 1), cum.swapaxes(0, 1)))
    y = y_intra + y_cross.swapaxes(0, 1) + x * d_skip.astype(f32).reshape(G, R)[:, :, None]
    y = y.reshape(b, L, SSD_D_INNER) * jax.nn.silu(z.astype(f32))
    y = _rms(y.reshape(b, L, G, SSD_D_INNER // G)).reshape(b, L, SSD_D_INNER) * norm_w.astype(f32)
    out = y.astype(h.dtype) @ w_out
    return out, s_fin.reshape(b, SSD_HEADS, P, N).astype(h.dtype), new_conv


def swiglu(h, w_gate, w_up, w_down):
    return (jax.nn.silu(h @ w_gate) * (h @ w_up)) @ w_down


def setup_inputs(seed: int = 0) -> dict:
    key = jax.random.key(seed)
    ks = jax.random.split(key, 24)
    f32 = jnp.float32
    nrm = lambda k, shape, scale: jax.random.normal(k, shape, f32) * scale
    dt0 = jnp.exp(jax.random.uniform(ks[13], (N_SSD, SSD_HEADS), f32)
                  * (math.log(0.1) - math.log(0.001)) + math.log(0.001))
    return {
        "x_prompt": nrm(ks[0], (BATCH, SEQ, D_MODEL), 1.0),
        "x_sample": nrm(ks[1], (DEC_BATCH, DEC_SEQ, D_MODEL), 1.0),
        "state_ret": nrm(ks[2], (N_RET, DEC_BATCH, RET_HEADS, RET_DK, RET_DV), 0.5),
        "state_ssm": nrm(ks[3], (N_SSD, DEC_BATCH, SSD_HEADS, SSD_HEADDIM, SSD_DSTATE), 0.5),
        "state_conv": nrm(ks[4], (N_SSD, DEC_BATCH, CONV_W - 1, CONV_DIM), 1.0),
        "ln_mix": 1.0 + nrm(ks[5], (DEPTH, D_MODEL), 0.01),
        "ln_ffn": 1.0 + nrm(ks[6], (DEPTH, D_MODEL), 0.01),
        "ln_final": 1.0 + nrm(ks[7], (D_MODEL,), 0.01),
        "ret_w_in": nrm(ks[8], (N_RET, D_MODEL, RET_IN), D_MODEL ** -0.5),
        "ret_w_out": nrm(ks[9], (N_RET, RET_V_DIM, D_MODEL), RET_V_DIM ** -0.5),
        "ssd_w_in": nrm(ks[10], (N_SSD, D_MODEL, SSD_IN), D_MODEL ** -0.5),
        "ssd_conv_w": nrm(ks[11], (N_SSD, CONV_W, CONV_DIM), CONV_W ** -0.5),
        "ssd_conv_b": nrm(ks[12], (N_SSD, CONV_DIM), 0.01),
        "ssd_dt_bias": dt0 + jnp.log(-jnp.expm1(-dt0)),
        "ssd_a_log": jnp.log(jax.random.uniform(ks[14], (N_SSD, SSD_HEADS), f32, 1.0, 16.0)),
        "ssd_d": 1.0 + nrm(ks[15], (N_SSD, SSD_HEADS), 0.1),
        "ssd_norm_w": 1.0 + nrm(ks[16], (N_SSD, SSD_D_INNER), 0.01),
        "ssd_w_out": nrm(ks[17], (N_SSD, SSD_D_INNER, D_MODEL), SSD_D_INNER ** -0.5),
        "ffn_w_gate": nrm(ks[18], (DEPTH, D_MODEL, D_FF), D_MODEL ** -0.5),
        "ffn_w_up": nrm(ks[19], (DEPTH, D_MODEL, D_FF), D_MODEL ** -0.5),
        "ffn_w_down": nrm(ks[20], (DEPTH, D_FF, D_MODEL), D_FF ** -0.5),
    }


def reference(x_prompt, x_sample, state_ret, state_ssm, state_conv, ln_mix, ln_ffn, ln_final,
              ret_w_in, ret_w_out, ssd_w_in, ssd_conv_w, ssd_conv_b, ssd_dt_bias, ssd_a_log,
              ssd_d, ssd_norm_w, ssd_w_out, ffn_w_gate, ffn_w_up, ffn_w_down):
    b_p, L_p, _ = x_prompt.shape
    L_s = x_sample.shape[1]
    pos_p = jnp.arange(L_p)
    pos_s = PAST_LEN + jnp.arange(L_s)
    xp, xs = x_prompt, x_sample
    ret_p, ret_s, ssm_p, ssm_s, conv_p, conv_s = [], [], [], [], [], []
    for i in range(DEPTH):
        j = i // N_MIXERS
        hp = rmsnorm(xp, ln_mix[i])
        hs = rmsnorm(xs, ln_mix[i])
        if i % N_MIXERS == 0:
            zero_ret = jnp.zeros((b_p, RET_HEADS, RET_DK, RET_DV), xp.dtype)
            yp, sp = retention_mixer(hp, pos_p, zero_ret, ret_w_in[j], ret_w_out[j])
            ys, ss = retention_mixer(hs, pos_s, state_ret[j], ret_w_in[j], ret_w_out[j])
            ret_p.append(sp)
            ret_s.append(ss)
        else:
            zero_conv = jnp.zeros((b_p, CONV_W - 1, CONV_DIM), xp.dtype)
            zero_ssm = jnp.zeros((b_p, SSD_HEADS, SSD_HEADDIM, SSD_DSTATE), xp.dtype)
            yp, sp, cp = ssd_mixer(hp, zero_conv, zero_ssm, ssd_w_in[j], ssd_conv_w[j], ssd_conv_b[j],
                                   ssd_dt_bias[j], ssd_a_log[j], ssd_d[j], ssd_norm_w[j], ssd_w_out[j])
            ys, ss, cs = ssd_mixer(hs, state_conv[j], state_ssm[j], ssd_w_in[j], ssd_conv_w[j],
                                   ssd_conv_b[j], ssd_dt_bias[j], ssd_a_log[j], ssd_d[j],
                                   ssd_norm_w[j], ssd_w_out[j])
            ssm_p.append(sp)
            ssm_s.append(ss)
            conv_p.append(cp)
            conv_s.append(cs)
        xp = xp + yp
        xs = xs + ys
        xp = xp + swiglu(rmsnorm(xp, ln_ffn[i]), ffn_w_gate[i], ffn_w_up[i], ffn_w_down[i])
        xs = xs + swiglu(rmsnorm(xs, ln_ffn[i]), ffn_w_gate[i], ffn_w_up[i], ffn_w_down[i])
    y_prompt = rmsnorm(xp, ln_final)
    y_sample = rmsnorm(xs, ln_final)
    return (y_prompt, y_sample, jnp.stack(ret_p), jnp.stack(ssm_p), jnp.stack(conv_p),
            jnp.stack(ret_s), jnp.stack(ssm_s), jnp.stack(conv_s))
```

```cpp
#include <hip/hip_runtime.h>
#include <cstdio>
#include <cstdint>
#include <cmath>

#ifndef MK_PER_PHASE
#define MK_PER_PHASE 0
#endif

#define LAS __attribute__((address_space(3)))
#define GAS __attribute__((address_space(1)))
typedef unsigned short bf16;
typedef short bf16x8 __attribute__((ext_vector_type(8)));
typedef short s16x4 __attribute__((ext_vector_type(4)));
typedef float f32x4 __attribute__((ext_vector_type(4)));
typedef float f32x2 __attribute__((ext_vector_type(2)));
typedef unsigned u32x4 __attribute__((ext_vector_type(4)));
typedef unsigned u32x2 __attribute__((ext_vector_type(2)));
typedef GAS unsigned gu32;

constexpr int DM = 2048;
constexpr int MROWS = 8704;
constexpr int MP = 8192;
constexpr int RET_IN = 12288, VDIM = 4096, FF = 5632, FF2 = 11264;
constexpr int SSD_IN = 10304, SSD_INP = 10496, CONVD = 6144;
constexpr int NPOS = 2112;
constexpr float EPS = 1e-6f;

constexpr size_t MiB = 1u << 20;
constexpr size_t WS_CTL = 0, CTL_BYTES = 2 * MiB;
constexpr size_t OFF_SSQ = 65536;
constexpr size_t OFF_SSQR = 262144;
constexpr size_t OFF_SSQS = 589824;
constexpr size_t WS_COS = 2 * MiB, WS_SIN = WS_COS + (size_t)NPOS * 128 * 4;
constexpr size_t WS_DT = 5 * MiB;
constexpr size_t WS_W = 8 * MiB;
constexpr int WPAD = 128;
constexpr size_t W_RIN = WS_W, W_ROUT = W_RIN + 51 * MiB, W_F0GU = W_ROUT + 17 * MiB, W_F0D = W_F0GU + 47 * MiB;
constexpr size_t W_SIN = W_F0D + 23 * MiB, W_SOUT = W_SIN + 44 * MiB, W_F1GU = W_SOUT + 17 * MiB, W_F1D = W_F1GU + 47 * MiB;
constexpr size_t WS_X = W_F1D + 23 * MiB;
constexpr size_t WS_XB = WS_X + 68 * MiB;
constexpr size_t WS_SCR = WS_XB + 34 * MiB;
constexpr size_t SC_Q = WS_SCR, SC_K = SC_Q + 34 * MiB, SC_V = SC_K + 34 * MiB, SC_G = SC_V + 68 * MiB;
constexpr size_t SC_H = WS_SCR;
constexpr size_t SC_H1 = WS_SCR + 68 * MiB;
constexpr size_t SC_Z = WS_SCR, SC_XBC = SC_Z + 68 * MiB;
constexpr size_t SC_XC = WS_W;
constexpr size_t WS_END = SC_G + 68 * MiB;
constexpr size_t SEAMCNT_OFF = 1 * MiB;
static_assert(W_RIN + (size_t)RET_IN * (DM + WPAD) * 2 <= W_ROUT && W_ROUT + (size_t)DM * (VDIM + WPAD) * 2 <= W_F0GU && W_F0GU + (size_t)FF2 * (DM + WPAD) * 2 <= W_F0D && W_F0D + (size_t)DM * (FF + WPAD) * 2 <= W_SIN && W_SIN + (size_t)SSD_INP * (DM + WPAD) * 2 <= W_SOUT && W_SOUT + (size_t)DM * (VDIM + WPAD) * 2 <= W_F1GU && W_F1GU + (size_t)FF2 * (DM + WPAD) * 2 <= W_F1D && W_F1D + (size_t)DM * (FF + WPAD) * 2 <= WS_X, "weights map");
static_assert(SC_H1 + (size_t)MROWS * FF * 2 <= WS_END && SC_XC + (size_t)MROWS * CONVD * 2 <= W_SIN && SC_XBC + (size_t)MROWS * CONVD * 2 <= WS_END && SC_H + (size_t)MROWS * FF * 2 <= WS_END, "overlay map");
static_assert(WS_X + (size_t)MROWS * DM * 4 <= WS_XB && WS_XB + (size_t)MROWS * DM * 2 <= WS_SCR, "x map");
constexpr size_t OUT_Y = 0, OUT_RETP = 17825792, OUT_SSMP = 22020096, OUT_CONVP = 24117248, OUT_RETS = 24190976, OUT_SSMS = 32579584, OUT_CONVS = 36773888, OUT_END = 36921344;

constexpr int LDS_BYTES = 156672;
constexpr int MISC_OFF = 155648;
constexpr int NWAVES = 8;

#define RLX_AGENT __ATOMIC_RELAXED, __HIP_MEMORY_SCOPE_AGENT
#define LDS_WAIT() asm volatile("s_waitcnt lgkmcnt(0)" ::: "memory")
#define VM_WAIT() asm volatile("s_waitcnt vmcnt(0)" ::: "memory")

typedef __bf16 bf16x2_t __attribute__((ext_vector_type(2)));
__device__ __forceinline__ unsigned cvt_pk_bf16(float lo, float hi) { const float __attribute__((ext_vector_type(2))) v = {lo, hi}; const bf16x2_t b = __builtin_convertvector(v, bf16x2_t); return __builtin_bit_cast(unsigned, b); }
__device__ __forceinline__ float bf_lo(unsigned w) { return __uint_as_float(w << 16); }
__device__ __forceinline__ float bf_hi(unsigned w) { return __uint_as_float(w & 0xffff0000u); }
__device__ __forceinline__ float fast_exp(float x) { return __builtin_amdgcn_exp2f(x * 1.44269504089f); }
__device__ __forceinline__ float softplus_f(float x) { const float t = __builtin_amdgcn_exp2f(-__builtin_fabsf(x) * 1.44269504089f); return __builtin_fmaxf(x, 0.f) + __builtin_amdgcn_logf(1.0f + t) * 0.69314718056f; }
__device__ __forceinline__ float silu_f(float x) { return x * __builtin_amdgcn_rcpf(1.0f + fast_exp(-x)); }
__device__ __forceinline__ float wave_scan_incl(float x) {
#define WS_DPP(v_, ctrl_, rmask_) __builtin_bit_cast(float, __builtin_amdgcn_update_dpp(0, __builtin_bit_cast(int, (v_)), (ctrl_), (rmask_), 0xf, false))
    float v = x;
    v += WS_DPP(v, 0x111, 0xf);
    v += WS_DPP(v, 0x112, 0xf);
    v += WS_DPP(v, 0x114, 0xf);
    v += WS_DPP(v, 0x118, 0xf);
    v += WS_DPP(v, 0x142, 0xa);
    v += WS_DPP(v, 0x143, 0xc);
#undef WS_DPP
    return v;
}
__device__ __forceinline__ float rows_sum4(float x) {
    float a = x, b = x;
    asm volatile("s_nop 1\n\tv_permlane16_swap_b32 %0, %1\n\ts_nop 1" : "+v"(a), "+v"(b));
    float c = a + b, d = c;
    asm volatile("s_nop 1\n\tv_permlane32_swap_b32 %0, %1\n\ts_nop 1" : "+v"(c), "+v"(d));
    return c + d;
}
__device__ __forceinline__ float wave_sum(float v) {
#pragma unroll
    for (int o = 1; o < 64; o <<= 1) v += __shfl_xor(v, o);
    return v;
}

__device__ __forceinline__ int fresh_lane() { int l; asm volatile("v_mbcnt_lo_u32_b32 %0, -1, 0\n\tv_mbcnt_hi_u32_b32 %0, -1, %0" : "=v"(l)); return l; }
__device__ __forceinline__ int fresh_tid(int wv) { return wv * 64 + fresh_lane(); }
namespace pg8 {
constexpr int BM = 256, BK = 64, HALF = 128, HTB = HALF * BK * 2, STAGE_BYTES = 8 * HTB, NXCD = 8, WGM = 8;
__host__ __device__ __forceinline__ int lds_byte(int r, int c) { const int st = (r >> 4) * 2 + (c >> 5), rr = r & 15, cc = c & 31, ob = rr * 64 + cc * 2; return st * 1024 + (ob ^ (((ob >> 9) & 1) << 5)); }
__host__ __device__ __forceinline__ void stage_rc(int b, int& R, int& C) { const int st = b / 1024, sb = b % 1024, swz = sb ^ (((sb >> 9) & 1) << 5); R = (st >> 1) * 16 + swz / 64; C = (st & 1) * 32 + (swz % 64) / 2; }
__host__ __device__ __forceinline__ int perm32(int rho) { const int n = rho >> 4, i = rho & 15; return 8 * (i >> 2) + 4 * n + (i & 3); }

struct Unit { int pm, pn; };
struct Gemm { const GAS bf16* A; const GAS bf16* Bt; int M, N, K; };
struct StaticOrder {
    int nM, nN, nwg, G, c;
    __device__ void init(int M, int N, int G_, int c_) { nM = M / BM; nN = N / BM; nwg = nM * nN; G = G_; c = c_; }
    __device__ bool next(int i, Unit& u) const {
        const long L = (long)i * G + c; if (L >= nwg) return false;
        int wgid = (int)L; { const int q = nwg / NXCD, r = nwg % NXCD, xcd = wgid % NXCD, off = wgid / NXCD; wgid = (xcd < r ? xcd * (q + 1) : r * (q + 1) + (xcd - r) * q) + off; }
        const int nig = WGM * nN, gid = wgid / nig, fm = gid * WGM, gsz = (nM - fm) < WGM ? (nM - fm) : WGM;
        u.pm = fm + ((wgid % nig) % gsz); u.pn = (wgid % nig) / gsz; return true;
    }
    __device__ __forceinline__ void a_ready(const Unit&, int) const {}
    __device__ __forceinline__ void done(int, int) const {}
};

struct TailOrder {
    StaticOrder so; int c, G; gu32* cnt;
    __device__ void init(int N, int G_, int c_, gu32* cnt_) { so.init(MP, N, G_, c_); c = c_; G = G_; cnt = cnt_; }
    __device__ bool next(int i, Unit& u) const {
        if (i == 0) return so.next(0, u);
        if (i == 1 && c >= G - 16) { u.pm = 32 + ((c - (G - 16)) >> 3); u.pn = (c - (G - 16)) & 7; return true; }
        return false;
    }
    __device__ __forceinline__ void a_ready(const Unit&, int) const {}
    __device__ __forceinline__ void done(int i, int) const {
        if (c < G - 16) return;
        asm volatile("s_waitcnt vmcnt(0)" ::: "memory");
        __builtin_amdgcn_fence(__ATOMIC_RELEASE, "agent");
        asm volatile("s_waitcnt vmcnt(0)" ::: "memory");
        if (fresh_lane() == 0) (void)__hip_atomic_fetch_add(cnt + (i ? 64 : 0), 1u, __ATOMIC_RELAXED, __HIP_MEMORY_SCOPE_AGENT);
    }
};
__device__ __forceinline__ void wait_count(gu32* p, unsigned want) {
    unsigned spins = 0;
    while ((unsigned)__builtin_amdgcn_readfirstlane(__hip_atomic_load(p, __ATOMIC_RELAXED, __HIP_MEMORY_SCOPE_AGENT)) < want) { __builtin_amdgcn_s_sleep(4); if (++spins > (1u << 24)) break; }
    __builtin_amdgcn_fence(__ATOMIC_ACQUIRE, "agent");
}
struct GuardOrder {
    StaticOrder so; gu32* cnt;
    __device__ void init(int M, int N, int G_, int c_, gu32* cnt_) { so.init(M, N, G_, c_); cnt = cnt_; }
    __device__ bool next(int i, Unit& u) const {
        const int c = so.c, G = so.G;
        if (c >= G - 16 && i >= 4) return false;
        if (c >= G - 40 && c < G - 24 && i == 5) { StaticOrder t = so; t.c = c + 24; return t.next(4, u); }
        return so.next(i, u);
    }
    __device__ __forceinline__ void a_ready(const Unit& u, int) const { if (u.pm >= 32) wait_count(cnt + 64, 128u); }
    __device__ __forceinline__ void done(int, int) const {}
};
template <class Epi, class Sched>
__device__ __forceinline__ void gemm_phase(LAS unsigned char* lds, const Gemm g, const Sched& S, const Epi& E, const int wv) {
    const int tid = fresh_tid(wv), wid = wv, lane = tid & 63, wr = wid >> 2, wc = wid & 3, fr = lane & 15, fq = lane >> 4;
    const int K = g.K, nt = K / BK;
    constexpr bool XR = Epi::XROWS;
    unsigned voffA[2], voffB[2];
#pragma unroll
    for (int i = 0; i < 2; ++i) { int R, C; stage_rc(tid * 16 + i * 8192, R, C); const int Rb = Epi::PERM ? ((R & ~31) + perm32(R & 31)) : R;
        voffA[i] = (unsigned)(R * K + C) * 2u; voffB[i] = (unsigned)(Rb * (K + WPAD) + C) * 2u; }
    const size_t kstep = (size_t)(BK * 2);
    const size_t hstepA = (size_t)HALF * K * 2, hstepB = hstepA + (size_t)HALF * WPAD * 2;
    const size_t tstepA = XR ? (size_t)272 * K * 2 : 2 * hstepA, tstepB = 2 * hstepB;
    const unsigned ldsw = (unsigned)wid * 1024u;
    const int aoff = lds_byte(wr * 64 + fr, fq * 8), boff = lds_byte(wc * 32 + fr, fq * 8);
    unsigned voffX = 0; const bool xl = lane < 16; const int xoff = lds_byte(fr, fq * 8);
    if constexpr (XR) { int R, C; stage_rc(wid * 256 + (lane & 15) * 16, R, C); voffX = (unsigned)((256 + R) * K + C) * 2u; }
#define PG8_STAGEX(b, gbase) do { if constexpr (XR) { if (xl) __builtin_amdgcn_global_load_lds((const GAS unsigned*)((const GAS char*)(gbase) + voffX), (LAS unsigned*)(lds + STAGE_BYTES + (b) * 2048 + wid * 256), 16, 0, 0); } } while (0)
#define PG8_LDX(b) do { if constexpr (XR) { _Pragma("unroll") for (int k = 0; k < 2; ++k) Ax[k] = *(const LAS bf16x8*)(lds + STAGE_BYTES + (b) * 2048 + xoff + k * 1024); } } while (0)
#define PG8_MMAX1(Bt) do { _Pragma("unroll") for (int n = 0; n < 2; ++n) _Pragma("unroll") for (int k = 0; k < 2; ++k) accx[n] = __builtin_amdgcn_mfma_f32_16x16x32_bf16(Bt[n][k], Ax[k], accx[n], 0, 0, 0); } while (0)
#define PG8_MMAX() do { if constexpr (XR) { if (wr) PG8_MMAX1(B1); else PG8_MMAX1(B0); } } while (0)
#define PG8_WAIT_VK() do { if constexpr (XR) asm volatile("s_waitcnt vmcnt(9)" ::: "memory"); else asm volatile("s_waitcnt vmcnt(8)" ::: "memory"); } while (0)
#define PG8_SA(b, h) (((b) * 2 + (h)) * HTB)
#define PG8_SB(b, h) ((4 + (b) * 2 + (h)) * HTB)
#define PG8_STAGE(bufoff, gbase, voff) do { _Pragma("unroll") for (int _i = 0; _i < 2; ++_i) \
        __builtin_amdgcn_global_load_lds((const GAS unsigned*)((const GAS char*)(gbase) + (voff)[_i]), (LAS unsigned*)(lds + (bufoff) + ldsw + _i * 8192), 16, 0, 0); } while (0)
#define PG8_LDA(dst, b, h) do { _Pragma("unroll") for (int m = 0; m < 4; ++m) _Pragma("unroll") for (int k = 0; k < 2; ++k) dst[m][k] = *(const LAS bf16x8*)(lds + PG8_SA(b, h) + aoff + m * 2048 + k * 1024); } while (0)
#define PG8_LDB(dst, b, h) do { _Pragma("unroll") for (int n = 0; n < 2; ++n) _Pragma("unroll") for (int k = 0; k < 2; ++k) dst[n][k] = *(const LAS bf16x8*)(lds + PG8_SB(b, h) + boff + n * 2048 + k * 1024); } while (0)
#define PG8_MMA(ai, bj, At, Bt) do { __builtin_amdgcn_s_setprio(1); _Pragma("unroll") for (int m = 0; m < 4; ++m) _Pragma("unroll") for (int n = 0; n < 2; ++n) _Pragma("unroll") for (int k = 0; k < 2; ++k) \
        acc[ai][bj][m][n] = __builtin_amdgcn_mfma_f32_16x16x32_bf16(Bt[n][k], At[m][k], acc[ai][bj][m][n], 0, 0, 0); __builtin_amdgcn_s_setprio(0); } while (0)
#define PG8_WAIT_V(n) asm volatile("s_waitcnt vmcnt(" #n ")" ::: "memory")
#define PG8_WAIT_L(n) asm volatile("s_waitcnt lgkmcnt(" #n ")" ::: "memory")
#define PG8_BAR __builtin_amdgcn_s_barrier()
#define PG8_SCHED __builtin_amdgcn_sched_barrier(0)
    Unit cur, nxt; int ui = 0;
    if (!S.next(0, cur)) return;
    f32x4 acc[2][2][4][2];
#pragma unroll
    for (int a = 0; a < 2; ++a)
#pragma unroll
        for (int b = 0; b < 2; ++b)
#pragma unroll
            for (int m = 0; m < 4; ++m)
#pragma unroll
                for (int n = 0; n < 2; ++n) acc[a][b][m][n] = (f32x4){0.f, 0.f, 0.f, 0.f};
    bf16x8 At[4][2], B0[2][2], B1[2][2], Ax[2];
    f32x4 accx[2] = {(f32x4){0.f, 0.f, 0.f, 0.f}, (f32x4){0.f, 0.f, 0.f, 0.f}};
    const GAS char* cA = (const GAS char*)g.A + (size_t)cur.pm * tstepA; const GAS char* cB = (const GAS char*)g.Bt + (size_t)cur.pn * tstepB;
    S.a_ready(cur, wv);
    PG8_STAGE(PG8_SB(0, 0), cB, voffB); PG8_STAGE(PG8_SB(0, 1), cB + hstepB, voffB); PG8_STAGE(PG8_SA(0, 0), cA, voffA); PG8_STAGE(PG8_SA(0, 1), cA + hstepA, voffA); PG8_STAGEX(0, cA);
    if (wr == 1) PG8_BAR;
    if constexpr (XR) PG8_WAIT_V(3); else PG8_WAIT_V(2);
    PG8_BAR;
    PG8_STAGE(PG8_SB(1, 0), cB + kstep, voffB); PG8_STAGE(PG8_SA(1, 0), cA + kstep, voffA); PG8_STAGE(PG8_SB(1, 1), cB + hstepB + kstep, voffB);
    PG8_WAIT_V(6); PG8_BAR;
    for (;;) {
        const bool has_next = S.next(ui + 1, nxt);
        const GAS char* nA = has_next ? (const GAS char*)g.A + (size_t)nxt.pm * tstepA : cA; const GAS char* nB = has_next ? (const GAS char*)g.Bt + (size_t)nxt.pn * tstepB : cB;
        for (int tseg = 0; tseg < nt; tseg += (Epi::HORNER ? 8 : nt)) {
        if constexpr (Epi::HORNER) { if (tseg != 0) { E.rescale(acc, cur, tseg >> 3, wv); if constexpr (XR) E.rescale_x(accx, cur, tseg >> 3, wv); } }
        const int tend = Epi::HORNER ? tseg + 8 : nt;
        for (int t = tseg; t < tend; t += 2) {
            const bool last = (t == nt - 2);
            const GAS char* a1 = cA + (size_t)(t + 1) * kstep;
            const GAS char* a2 = last ? nA : cA + (size_t)(t + 2) * kstep; const GAS char* b2 = last ? nB : cB + (size_t)(t + 2) * kstep;
            const GAS char* a3 = a2 + kstep; const GAS char* b3 = b2 + kstep;
            if (last && has_next) S.a_ready(nxt, wv);
            PG8_LDB(B0, 0, 0); PG8_LDB(B1, 0, 1); PG8_SCHED; PG8_LDA(At, 0, 0); PG8_STAGE(PG8_SA(1, 1), a1 + hstepA, voffA); PG8_STAGEX(1, a1);
            PG8_WAIT_VK(); PG8_WAIT_L(0); PG8_BAR; PG8_MMA(0, 0, At, B0); PG8_MMA(0, 1, At, B1); PG8_BAR; PG8_SCHED;
            PG8_LDA(At, 0, 1); PG8_LDX(0); PG8_STAGE(PG8_SB(0, 0), b2, voffB); PG8_STAGE(PG8_SB(0, 1), b2 + hstepB, voffB); PG8_STAGE(PG8_SA(0, 0), a2, voffA);
            PG8_WAIT_VK(); PG8_WAIT_L(0); PG8_BAR; PG8_MMA(1, 0, At, B0); PG8_MMA(1, 1, At, B1); PG8_MMAX(); PG8_BAR; PG8_SCHED;
            PG8_LDB(B0, 1, 0); PG8_LDB(B1, 1, 1); PG8_SCHED; PG8_LDA(At, 1, 0); PG8_STAGE(PG8_SA(0, 1), a2 + hstepA, voffA); PG8_STAGEX(0, a2);
            PG8_WAIT_VK(); PG8_WAIT_L(0); PG8_BAR; PG8_MMA(0, 0, At, B0); PG8_MMA(0, 1, At, B1); PG8_BAR; PG8_SCHED;
            PG8_LDA(At, 1, 1); PG8_LDX(1); PG8_STAGE(PG8_SB(1, 0), b3, voffB); PG8_STAGE(PG8_SB(1, 1), b3 + hstepB, voffB); PG8_STAGE(PG8_SA(1, 0), a3, voffA);
            PG8_WAIT_VK(); PG8_WAIT_L(0); PG8_BAR; PG8_MMA(1, 0, At, B0); PG8_MMA(1, 1, At, B1); PG8_MMAX(); PG8_BAR; PG8_SCHED;
        }
        }
        if (wr == 0) PG8_BAR;
        if constexpr (Epi::FINAL) E.final(acc, accx, cur, wv);
        else { E(acc, cur, wv); if constexpr (XR) E.extra(accx, cur, wv); }
        S.done(ui, wv);
        if (!has_next) break;
#pragma unroll
        for (int a = 0; a < 2; ++a)
#pragma unroll
            for (int b = 0; b < 2; ++b)
#pragma unroll
                for (int m = 0; m < 4; ++m)
#pragma unroll
                    for (int n = 0; n < 2; ++n) acc[a][b][m][n] = (f32x4){0.f, 0.f, 0.f, 0.f};
        accx[0] = (f32x4){0.f, 0.f, 0.f, 0.f}; accx[1] = accx[0];
        cur = nxt; cA = nA; cB = nB; ++ui;
        if (wr == 1) PG8_BAR;
    }
    PG8_WAIT_V(0);
    PG8_BAR;
#undef PG8_SA
#undef PG8_SB
#undef PG8_STAGE
#undef PG8_STAGEX
#undef PG8_LDX
#undef PG8_MMAX1
#undef PG8_MMAX
#undef PG8_WAIT_VK
#undef PG8_LDA
#undef PG8_LDB
#undef PG8_MMA
#undef PG8_WAIT_V
#undef PG8_WAIT_L
#undef PG8_BAR
#undef PG8_SCHED
}
}

struct LaneIdx { int wr, wc, fr, fq; };
__device__ __forceinline__ LaneIdx lane_idx(int wv) { const int t = fresh_lane(); LaneIdx L; L.wr = wv >> 2; L.wc = wv & 3; L.fr = t & 15; L.fq = (t >> 4) & 3; return L; }
__device__ __forceinline__ u32x4 pack8(const f32x4 a, const f32x4 b) { u32x4 w; w.x = cvt_pk_bf16(a[0], a[1]); w.y = cvt_pk_bf16(a[2], a[3]); w.z = cvt_pk_bf16(b[0], b[1]); w.w = cvt_pk_bf16(b[2], b[3]); return w; }
__device__ __forceinline__ f32x4 silu4(f32x4 v) { f32x4 o; o[0] = silu_f(v[0]); o[1] = silu_f(v[1]); o[2] = silu_f(v[2]); o[3] = silu_f(v[3]); return o; }

struct EpiRetIn {
    static constexpr bool PERM = true, HORNER = false, XROWS = true, FINAL = true;
    static constexpr int BMR = 272;
    LAS float* xch;
    GAS bf16* Q; GAS bf16* Kb; GAS bf16* V; GAS bf16* G; const GAS float* ssq; const GAS double* invrev;
    __device__ __forceinline__ void rescale(f32x4 (&)[2][2][4][2], const pg8::Unit&, int, int) const {}
    __device__ __forceinline__ void rescale_x(f32x4 (&)[2], const pg8::Unit&, int, int) const {}
    __device__ __forceinline__ void final(f32x4 (&acc)[2][2][4][2], f32x4 (&accx)[2], const pg8::Unit& u, const int wv) const {
        const LaneIdx L_ = lane_idx(wv); const int wr = L_.wr, wc = L_.wc, fr = L_.fr, fq = L_.fq;
        const int row0 = u.pm * BMR + wr * 64 + fr, rowx = u.pm * BMR + 256 + fr, pn = u.pn, d0 = wc * 32 + 8 * fq, lane = fq * 16 + fr;
        float rsv[2][4];
#pragma unroll
        for (int ai = 0; ai < 2; ++ai)
#pragma unroll
            for (int m = 0; m < 4; ++m) rsv[ai][m] = ssq[row0 + ai * 128 + m * 16];
        const float rsx0 = ssq[rowx];
        if (pn < 16) {
            float fq8[8];
#pragma unroll
            for (int j = 0; j < 8; ++j) fq8[j] = (float)invrev[d0 + j];
            LAS f32x4* mine = (LAS f32x4*)(xch + (wv * 64 + lane) * 8); mine[0] = accx[0]; mine[1] = accx[1];
            asm volatile("s_waitcnt lgkmcnt(0)" ::: "memory"); __builtin_amdgcn_s_barrier();
            const LAS f32x4* oth = (const LAS f32x4*)(xch + ((wv ^ 4) * 64 + lane) * 8); const f32x4 pa = oth[0], pb = oth[1];
            const bool isk = pn >= 8; const int h = pn & 7; GAS bf16* dst = (isk ? Kb : Q) + h * 256 + d0; const float sc = isk ? 0.0625f : 1.0f;
#pragma unroll
            for (int ai = 0; ai < 2; ++ai)
#pragma unroll
                for (int m = 0; m < 4; ++m) {
                    const int row = row0 + ai * 128 + m * 16;
                    const float rs = __builtin_amdgcn_rsqf(rsv[ai][m] * (1.0f / DM) + EPS) * sc;
                    const float pos = (float)(row < MP ? (row & 2047) : 4096 + ((row - MP) & 63));
                    f32x4 c0, c1, s0, s1;
#pragma unroll
                    for (int j = 0; j < 4; ++j) { const float r0 = __builtin_amdgcn_fractf(pos * fq8[j]), r1 = __builtin_amdgcn_fractf(pos * fq8[4 + j]);
                        c0[j] = __builtin_amdgcn_cosf(r0); s0[j] = __builtin_amdgcn_sinf(r0); c1[j] = __builtin_amdgcn_cosf(r1); s1[j] = __builtin_amdgcn_sinf(r1); }
                    const f32x4 x1a = acc[ai][0][m][0], x1b = acc[ai][0][m][1], x2a = acc[ai][1][m][0], x2b = acc[ai][1][m][1];
                    const f32x4 o1a = (x1a * c0 - x2a * s0) * rs, o1b = (x1b * c1 - x2b * s1) * rs;
                    const f32x4 o2a = (x2a * c0 + x1a * s0) * rs, o2b = (x2b * c1 + x1b * s1) * rs;
                    *(GAS u32x4*)(dst + (size_t)row * DM) = pack8(o1a, o1b);
                    *(GAS u32x4*)(dst + (size_t)row * DM + 128) = pack8(o2a, o2b);
                }
            { const float rs = __builtin_amdgcn_rsqf(rsx0 * (1.0f / DM) + EPS) * sc;
              const float pos = (float)(rowx < MP ? (rowx & 2047) : 4096 + ((rowx - MP) & 63));
              f32x4 c0, c1, s0, s1;
#pragma unroll
              for (int j = 0; j < 4; ++j) { const float r0 = __builtin_amdgcn_fractf(pos * fq8[j]), r1 = __builtin_amdgcn_fractf(pos * fq8[4 + j]);
                  c0[j] = __builtin_amdgcn_cosf(r0); s0[j] = __builtin_amdgcn_sinf(r0); c1[j] = __builtin_amdgcn_cosf(r1); s1[j] = __builtin_amdgcn_sinf(r1); }
              if (wr) { s0 = -s0; s1 = -s1; }
              const f32x4 oa = (accx[0] * c0 - pa * s0) * rs, ob = (accx[1] * c1 - pb * s1) * rs;
              *(GAS u32x4*)(dst + wr * 128 + (size_t)rowx * DM) = pack8(oa, ob); }
        } else {
            const bool isg = pn >= 32; GAS bf16* dst = (isg ? G : V) + ((pn - 16) & 15) * 256 + d0;
#pragma unroll
            for (int ai = 0; ai < 2; ++ai)
#pragma unroll
                for (int m = 0; m < 4; ++m) {
                    const int row = row0 + ai * 128 + m * 16;
                    const float rs = __builtin_amdgcn_rsqf(rsv[ai][m] * (1.0f / DM) + EPS);
#pragma unroll
                    for (int bj = 0; bj < 2; ++bj) {
                        f32x4 v0 = acc[ai][bj][m][0] * rs, v1 = acc[ai][bj][m][1] * rs;
                        if (isg) { v0 = silu4(v0); v1 = silu4(v1); }
                        *(GAS u32x4*)(dst + (size_t)row * VDIM + bj * 128) = pack8(v0, v1);
                    }
                }
            { const float rs = __builtin_amdgcn_rsqf(rsx0 * (1.0f / DM) + EPS);
              f32x4 v0 = accx[0] * rs, v1 = accx[1] * rs;
              if (isg) { v0 = silu4(v0); v1 = silu4(v1); }
              *(GAS u32x4*)(dst + wr * 128 + (size_t)rowx * VDIM) = pack8(v0, v1); }
        }
    }
};

struct EpiFfnGU {
    static constexpr bool PERM = true, HORNER = false, XROWS = false, FINAL = false;
    GAS bf16* H; const GAS float* ssq;
    __device__ __forceinline__ void rescale(f32x4 (&)[2][2][4][2], const pg8::Unit&, int, int) const {}
    __device__ __forceinline__ void operator()(const f32x4 (&acc)[2][2][4][2], const pg8::Unit& u, const int wv) const {
        const LaneIdx L_ = lane_idx(wv); const int wr = L_.wr, wc = L_.wc, fr = L_.fr, fq = L_.fq; (void)wr; (void)wc; (void)fr; (void)fq;
        const int row0 = u.pm * 256 + wr * 64 + fr; GAS bf16* dst = H + u.pn * 128 + wc * 32 + 8 * fq;
        float rsv[2][4];
#pragma unroll
        for (int ai = 0; ai < 2; ++ai)
#pragma unroll
            for (int m = 0; m < 4; ++m) rsv[ai][m] = ssq[row0 + ai * 128 + m * 16];
#pragma unroll
        for (int ai = 0; ai < 2; ++ai)
#pragma unroll
            for (int m = 0; m < 4; ++m) {
                const int row = row0 + ai * 128 + m * 16;
                const float rs = __builtin_amdgcn_rsqf(rsv[ai][m] * (1.0f / DM) + EPS);
                const f32x4 g0 = silu4(acc[ai][0][m][0] * rs), g1 = silu4(acc[ai][0][m][1] * rs);
                const f32x4 u0 = acc[ai][1][m][0] * rs, u1 = acc[ai][1][m][1] * rs;
                *(GAS u32x4*)(dst + (size_t)row * FF) = pack8(g0 * u0, g1 * u1);
            }
    }
};

template <bool HORN, bool XRW = false> struct EpiResid {
    static constexpr bool PERM = true, HORNER = HORN, XROWS = XRW, FINAL = XRW;
    static constexpr int BMR = XRW ? 272 : 256;
    GAS bf16* xb; GAS float* ssq_out; const GAS float* ssn; const GAS float* xin0; const GAS float* xin1;
    __device__ __forceinline__ void rescale(f32x4 (&acc)[2][2][4][2], const pg8::Unit& u, int seg, const int wv) const {
        const LaneIdx L_ = lane_idx(wv); const int wr = L_.wr, fr = L_.fr;
        const unsigned voff = (unsigned)(wr * 64 + fr) * 32u;
        const GAS char* base = (const GAS char*)(ssn + (size_t)u.pm * BMR * 8 + seg - 1);
        float a0[2][4], b0[2][4];
#pragma unroll
        for (int ai = 0; ai < 2; ++ai)
#pragma unroll
            for (int m = 0; m < 4; ++m) { a0[ai][m] = *(const GAS float*)(base + (ai * 128 + m * 16) * 32 + voff); b0[ai][m] = *(const GAS float*)(base + (ai * 128 + m * 16) * 32 + 4 + voff); }
#pragma unroll
        for (int ai = 0; ai < 2; ++ai)
#pragma unroll
            for (int m = 0; m < 4; ++m) {
                const float a = a0[ai][m] * (1.0f / 512) + EPS, b = b0[ai][m] * (1.0f / 512) + EPS;
                const float r = __builtin_amdgcn_sqrtf(b * __builtin_amdgcn_rcpf(a));
#pragma unroll
                for (int bj = 0; bj < 2; ++bj)
#pragma unroll
                    for (int n = 0; n < 2; ++n) acc[ai][bj][m][n] = acc[ai][bj][m][n] * r;
            }
    }
    __device__ __forceinline__ void operator()(const f32x4 (&acc)[2][2][4][2], const pg8::Unit& u, const int wv) const {
        const LaneIdx L_ = lane_idx(wv); const int wr = L_.wr, wc = L_.wc, fr = L_.fr, fq = L_.fq; (void)wr; (void)wc; (void)fr; (void)fq;
        const int row0 = u.pm * BMR + wr * 64 + fr, col0 = u.pn * 256 + wc * 32 + 8 * fq;
#pragma unroll
        for (int ai = 0; ai < 2; ++ai)
#pragma unroll
            for (int m = 0; m < 4; ++m) {
                const int row = row0 + ai * 128 + m * 16;
                float sc = 1.0f; if (HORN) sc = __builtin_amdgcn_rsqf(ssn[row * 8 + 7] * (1.0f / 512) + EPS);
                float sq = 0.f;
#pragma unroll
                for (int bj = 0; bj < 2; ++bj) {
                    const size_t o = (size_t)row * DM + col0 + bj * 128;
                    f32x4 x0, x1;
                    if (xin0) { const GAS float* xs_ = row < MP ? xin0 + o : xin1 + (o - (size_t)MP * DM); x0 = *(const GAS f32x4*)xs_; x1 = *(const GAS f32x4*)(xs_ + 4); }
                    else { const u32x4 w = *(const GAS u32x4*)(xb + o); x0 = (f32x4){bf_lo(w.x), bf_hi(w.x), bf_lo(w.y), bf_hi(w.y)}; x1 = (f32x4){bf_lo(w.z), bf_hi(w.z), bf_lo(w.w), bf_hi(w.w)}; }
                    x0 = x0 + acc[ai][bj][m][0] * sc; x1 = x1 + acc[ai][bj][m][1] * sc;
                    *(GAS u32x4*)(xb + o) = pack8(x0, x1);
                    sq += ((x0[0] * x0[0] + x0[1] * x0[1]) + (x0[2] * x0[2] + x0[3] * x0[3])) + ((x1[0] * x1[0] + x1[1] * x1[1]) + (x1[2] * x1[2] + x1[3] * x1[3]));
                }
                sq = rows_sum4(sq);
                if (fq == 0) (void)__hip_atomic_fetch_add(ssq_out + row, sq, __ATOMIC_RELAXED, __HIP_MEMORY_SCOPE_AGENT);
                asm volatile("" ::: "memory");
            }
    }
    __device__ __forceinline__ void final(f32x4 (&acc)[2][2][4][2], f32x4 (&accx)[2], const pg8::Unit& u, const int wv) const {
        const LaneIdx L_ = lane_idx(wv); const int wr = L_.wr, wc = L_.wc, fr = L_.fr, fq = L_.fq;
        const int rowx = u.pm * BMR + 256 + fr;
        const size_t ox = (size_t)rowx * DM + u.pn * 256 + wr * 128 + wc * 32 + 8 * fq;
        float scx = 1.0f; if (HORN) scx = ssn[rowx * 8 + 7];
        f32x4 x0, x1;
        if (xin0) { const GAS float* xs_ = rowx < MP ? xin0 + ox : xin1 + (ox - (size_t)MP * DM); x0 = *(const GAS f32x4*)xs_; x1 = *(const GAS f32x4*)(xs_ + 4); }
        else { const u32x4 w = *(const GAS u32x4*)(xb + ox); x0 = (f32x4){bf_lo(w.x), bf_hi(w.x), bf_lo(w.y), bf_hi(w.y)}; x1 = (f32x4){bf_lo(w.z), bf_hi(w.z), bf_lo(w.w), bf_hi(w.w)}; }
        (*this)(acc, u, wv);
        if (HORN) scx = __builtin_amdgcn_rsqf(scx * (1.0f / 512) + EPS);
        x0 = x0 + accx[0] * scx; x1 = x1 + accx[1] * scx;
        *(GAS u32x4*)(xb + ox) = pack8(x0, x1);
        float sq = ((x0[0] * x0[0] + x0[1] * x0[1]) + (x0[2] * x0[2] + x0[3] * x0[3])) + ((x1[0] * x1[0] + x1[1] * x1[1]) + (x1[2] * x1[2] + x1[3] * x1[3]));
        sq = rows_sum4(sq);
        if (fq == 0) (void)__hip_atomic_fetch_add(ssq_out + rowx, sq, __ATOMIC_RELAXED, __HIP_MEMORY_SCOPE_AGENT);
    }
    __device__ __forceinline__ void rescale_x(f32x4 (&accx)[2], const pg8::Unit& u, int seg, const int wv) const {
        const LaneIdx L_ = lane_idx(wv);
        const GAS float* p = ssn + ((size_t)u.pm * BMR + 256 + L_.fr) * 8 + seg - 1;
        const float a = p[0] * (1.0f / 512) + EPS, b = p[1] * (1.0f / 512) + EPS;
        const float r = __builtin_amdgcn_sqrtf(b * __builtin_amdgcn_rcpf(a));
        accx[0] = accx[0] * r; accx[1] = accx[1] * r;
    }
    __device__ __forceinline__ void extra(const f32x4 (&accx)[2], const pg8::Unit& u, const int wv) const {
        const LaneIdx L_ = lane_idx(wv); const int wr = L_.wr, wc = L_.wc, fr = L_.fr, fq = L_.fq;
        const int row = u.pm * BMR + 256 + fr;
        float sc = 1.0f; if (HORN) sc = __builtin_amdgcn_rsqf(ssn[row * 8 + 7] * (1.0f / 512) + EPS);
        const size_t o = (size_t)row * DM + u.pn * 256 + wr * 128 + wc * 32 + 8 * fq;
        f32x4 x0, x1;
        if (xin0) { const GAS float* xs_ = row < MP ? xin0 + o : xin1 + (o - (size_t)MP * DM); x0 = *(const GAS f32x4*)xs_; x1 = *(const GAS f32x4*)(xs_ + 4); }
        else { const u32x4 w = *(const GAS u32x4*)(xb + o); x0 = (f32x4){bf_lo(w.x), bf_hi(w.x), bf_lo(w.y), bf_hi(w.y)}; x1 = (f32x4){bf_lo(w.z), bf_hi(w.z), bf_lo(w.w), bf_hi(w.w)}; }
        x0 = x0 + accx[0] * sc; x1 = x1 + accx[1] * sc;
        *(GAS u32x4*)(xb + o) = pack8(x0, x1);
        float sq = ((x0[0] * x0[0] + x0[1] * x0[1]) + (x0[2] * x0[2] + x0[3] * x0[3])) + ((x1[0] * x1[0] + x1[1] * x1[1]) + (x1[2] * x1[2] + x1[3] * x1[3]));
        sq = rows_sum4(sq);
        if (fq == 0) (void)__hip_atomic_fetch_add(ssq_out + row, sq, __ATOMIC_RELAXED, __HIP_MEMORY_SCOPE_AGENT);
    }
};

struct EpiFinal {
    static constexpr bool PERM = true, HORNER = false, XROWS = true, FINAL = true;
    static constexpr int BMR = 272;
    const GAS bf16* xb; GAS float* ssq; const GAS float* lnw; GAS float* y; gu32* cnt;
    __device__ __forceinline__ void rescale(f32x4 (&)[2][2][4][2], const pg8::Unit&, int, int) const {}
    __device__ __forceinline__ void rescale_x(f32x4 (&)[2], const pg8::Unit&, int, int) const {}
    __device__ __forceinline__ void final(f32x4 (&acc)[2][2][4][2], f32x4 (&accx)[2], const pg8::Unit& u, const int wv) const {
        const LaneIdx L_ = lane_idx(wv); const int wr = L_.wr, wc = L_.wc, fr = L_.fr, fq = L_.fq;
        const int row0 = u.pm * BMR + wr * 64 + fr, col0 = u.pn * 256 + wc * 32 + 8 * fq;
        const int rowx = u.pm * BMR + 256 + fr, colx = u.pn * 256 + wr * 128 + wc * 32 + 8 * fq;
#pragma unroll
        for (int ai = 0; ai < 2; ++ai)
#pragma unroll
            for (int m = 0; m < 4; ++m) {
                const int row = row0 + ai * 128 + m * 16;
                float sq = 0.f;
#pragma unroll
                for (int bj = 0; bj < 2; ++bj) {
                    const u32x4 w = *(const GAS u32x4*)(xb + (size_t)row * DM + col0 + bj * 128);
                    const f32x4 x0 = (f32x4){bf_lo(w.x), bf_hi(w.x), bf_lo(w.y), bf_hi(w.y)} + acc[ai][bj][m][0], x1 = (f32x4){bf_lo(w.z), bf_hi(w.z), bf_lo(w.w), bf_hi(w.w)} + acc[ai][bj][m][1];
                    acc[ai][bj][m][0] = x0; acc[ai][bj][m][1] = x1;
                    sq += ((x0[0] * x0[0] + x0[1] * x0[1]) + (x0[2] * x0[2] + x0[3] * x0[3])) + ((x1[0] * x1[0] + x1[1] * x1[1]) + (x1[2] * x1[2] + x1[3] * x1[3]));
                }
                sq = rows_sum4(sq);
                if (fq == 0) (void)__hip_atomic_fetch_add(ssq + row, sq, __ATOMIC_RELAXED, __HIP_MEMORY_SCOPE_AGENT);
                asm volatile("" ::: "memory");
            }
        { const u32x4 w = *(const GAS u32x4*)(xb + (size_t)rowx * DM + colx);
          const f32x4 x0 = (f32x4){bf_lo(w.x), bf_hi(w.x), bf_lo(w.y), bf_hi(w.y)} + accx[0], x1 = (f32x4){bf_lo(w.z), bf_hi(w.z), bf_lo(w.w), bf_hi(w.w)} + accx[1];
          accx[0] = x0; accx[1] = x1;
          float sq = ((x0[0] * x0[0] + x0[1] * x0[1]) + (x0[2] * x0[2] + x0[3] * x0[3])) + ((x1[0] * x1[0] + x1[1] * x1[1]) + (x1[2] * x1[2] + x1[3] * x1[3]));
          sq = rows_sum4(sq);
          if (fq == 0) (void)__hip_atomic_fetch_add(ssq + rowx, sq, __ATOMIC_RELAXED, __HIP_MEMORY_SCOPE_AGENT); }
        asm volatile("s_waitcnt vmcnt(0)" ::: "memory");
        __builtin_amdgcn_s_barrier();
        if (fresh_tid(wv) == 0) {
            gu32* c = cnt + u.pm * 64;
            __builtin_amdgcn_fence(__ATOMIC_RELEASE, "agent");
            asm volatile("s_waitcnt vmcnt(0)" ::: "memory");
            (void)__hip_atomic_fetch_add(c, 1u, __ATOMIC_RELAXED, __HIP_MEMORY_SCOPE_AGENT);
            unsigned sp = 0;
            while (__hip_atomic_load(c, __ATOMIC_RELAXED, __HIP_MEMORY_SCOPE_AGENT) < 8u) { __builtin_amdgcn_s_sleep(2); if (++sp > (1u << 22)) break; }
            __builtin_amdgcn_fence(__ATOMIC_ACQUIRE, "agent");
            asm volatile("s_waitcnt vmcnt(0)" ::: "memory");
        }
        __builtin_amdgcn_s_barrier();
        f32x4 lw[2][2];
#pragma unroll
        for (int bj = 0; bj < 2; ++bj) { lw[bj][0] = *(const GAS f32x4*)(lnw + col0 + bj * 128); lw[bj][1] = *(const GAS f32x4*)(lnw + col0 + bj * 128 + 4); }
        float sv[2][4];
#pragma unroll
        for (int ai = 0; ai < 2; ++ai)
#pragma unroll
            for (int m = 0; m < 4; ++m) sv[ai][m] = __hip_atomic_load(ssq + row0 + ai * 128 + m * 16, __ATOMIC_RELAXED, __HIP_MEMORY_SCOPE_AGENT);
        const float svx = __hip_atomic_load(ssq + rowx, __ATOMIC_RELAXED, __HIP_MEMORY_SCOPE_AGENT);
        const f32x4 lwx0 = *(const GAS f32x4*)(lnw + colx), lwx1 = *(const GAS f32x4*)(lnw + colx + 4);
#pragma unroll
        for (int ai = 0; ai < 2; ++ai)
#pragma unroll
            for (int m = 0; m < 4; ++m) {
                const int row = row0 + ai * 128 + m * 16;
                const float rs = __builtin_amdgcn_rsqf(sv[ai][m] * (1.0f / DM) + EPS);
#pragma unroll
                for (int bj = 0; bj < 2; ++bj) {
                    GAS float* d = y + (size_t)row * DM + col0 + bj * 128;
                    *(GAS f32x4*)d = acc[ai][bj][m][0] * rs * lw[bj][0]; *(GAS f32x4*)(d + 4) = acc[ai][bj][m][1] * rs * lw[bj][1];
                }
            }
        { const float rs = __builtin_amdgcn_rsqf(svx * (1.0f / DM) + EPS);
          GAS float* d = y + (size_t)rowx * DM + colx;
          *(GAS f32x4*)d = accx[0] * rs * lwx0; *(GAS f32x4*)(d + 4) = accx[1] * rs * lwx1; }
    }
};

struct EpiSsdIn {
    static constexpr bool PERM = true, HORNER = false, XROWS = false, FINAL = false;
    GAS bf16* Z; GAS bf16* XBC; GAS float* DT; const GAS float* ssq; const GAS float* dt_bias; GAS float* convP; GAS float* convS;
    __device__ __forceinline__ void rescale(f32x4 (&)[2][2][4][2], const pg8::Unit&, int, int) const {}
    __device__ __forceinline__ void operator()(const f32x4 (&acc)[2][2][4][2], const pg8::Unit& u, const int wv) const {
        const LaneIdx L_ = lane_idx(wv); const int wr = L_.wr, wc = L_.wc, fr = L_.fr, fq = L_.fq; (void)wr; (void)wc; (void)fr; (void)fq;
        const int row0 = u.pm * 256 + wr * 64 + fr, pn = u.pn, c0 = wc * 32 + 8 * fq;
        float rsv[2][4];
#pragma unroll
        for (int ai = 0; ai < 2; ++ai)
#pragma unroll
            for (int m = 0; m < 4; ++m) rsv[ai][m] = ssq[row0 + ai * 128 + m * 16];
#pragma unroll
        for (int ai = 0; ai < 2; ++ai)
#pragma unroll
            for (int m = 0; m < 4; ++m) {
                const int row = row0 + ai * 128 + m * 16;
                const float rs = __builtin_amdgcn_rsqf(rsv[ai][m] * (1.0f / DM) + EPS);
                if (pn < 16) {
#pragma unroll
                    for (int bj = 0; bj < 2; ++bj) {
                        *(GAS u32x4*)(Z + (size_t)row * VDIM + pn * 256 + bj * 128 + c0) = pack8(silu4(acc[ai][bj][m][0] * rs), silu4(acc[ai][bj][m][1] * rs));
                    }
                } else if (pn < 40) {
                    int t3 = -1; GAS float* cdst = nullptr;
                    if (row < MP) { const int t = row & 2047; if (t >= 2045) { t3 = t - 2045; cdst = convP + (size_t)((row >> 11) * 3 + t3) * CONVD; } }
                    else { const int rr = row - MP, t = rr & 63; if (t >= 61) { t3 = t - 61; cdst = convS + (size_t)((rr >> 6) * 3 + t3) * CONVD; } }
#pragma unroll
                    for (int bj = 0; bj < 2; ++bj) {
                        const int col = (pn - 16) * 256 + bj * 128 + c0;
                        const f32x4 v0 = acc[ai][bj][m][0] * rs, v1 = acc[ai][bj][m][1] * rs;
                        *(GAS u32x4*)(XBC + (size_t)row * CONVD + col) = pack8(v0, v1);
                        if (t3 >= 0) { *(GAS f32x4*)(cdst + col) = v0; *(GAS f32x4*)(cdst + col + 4) = v1; }
                    }
                } else if (wc < 2) {
                    const f32x4 b0 = *(const GAS f32x4*)(dt_bias + c0), b1 = *(const GAS f32x4*)(dt_bias + c0 + 4);
                    f32x4 v0 = acc[ai][0][m][0] * rs + b0, v1 = acc[ai][0][m][1] * rs + b1;
#pragma unroll
                    for (int j = 0; j < 4; ++j) { v0[j] = softplus_f(v0[j]); v1[j] = softplus_f(v1[j]); }
                    *(GAS f32x4*)(DT + (size_t)row * 64 + c0) = v0; *(GAS f32x4*)(DT + (size_t)row * 64 + c0 + 4) = v1;
                }
            }
    }
};

template <int OFF0, int OFF1> __device__ __forceinline__ bf16x8 tr_frag_i(unsigned base) {
    const s16x4 lo = __builtin_amdgcn_ds_read_tr16_b64_v4i16((LAS s16x4*)(uintptr_t)(base + OFF0));
    const s16x4 hi = __builtin_amdgcn_ds_read_tr16_b64_v4i16((LAS s16x4*)(uintptr_t)(base + OFF1));
    return __builtin_shufflevector(lo, hi, 0, 1, 2, 3, 4, 5, 6, 7);
}
template <int OFF, int ROWSTEP> __device__ __forceinline__ void tr_frag4(unsigned base, bf16x8& f0, bf16x8& f1, bf16x8& f2, bf16x8& f3) {
    f0 = tr_frag_i<OFF, OFF + ROWSTEP>(base); f1 = tr_frag_i<OFF + 32, OFF + 32 + ROWSTEP>(base);
    f2 = tr_frag_i<OFF + 64, OFF + 64 + ROWSTEP>(base); f3 = tr_frag_i<OFF + 96, OFF + 96 + ROWSTEP>(base);
}
struct ScanItem {
    const GAS bf16* qg; const GAS bf16* kg; const GAS bf16* vg; int ldq, ldv;
    const GAS bf16* gg; GAS bf16* yg; int ldg;
    GAS float* ssqg; int ssq_col;
    int rowbase, nsteps;
    const GAS float* s_in; GAS float* s_out; int sd, se;
    float lg2;
    const GAS float* dtg; float Ah, Dh;
};
template <int MODE>
__device__ __forceinline__ void scan_chain(LAS unsigned char* lds, const ScanItem& it, const int wv) {
    constexpr int DK = MODE ? 128 : 256, RSQ = 2 * DK + 32, RSV = 144, NQC = DK / 64, DH = DK / 2, NDT = DH / 16, NK3 = DH / 32, NK1 = DK / 32, CPR = DK / 8;
    constexpr int RST = RSQ - 16;
    constexpr int O_QI = 0, O_KI = 64 * RSQ, O_ST = 2 * 64 * RSQ, O_VI = 3 * 64 * RSQ, O_VS = O_VI + 64 * RSV, O_PI = O_VS + 64 * RSV, O_XC = O_PI + 64 * RSV, O_SSQ = O_XC + 16384;
    static_assert(O_SSQ + 512 + 512 <= MISC_OFF, "scan LDS");
    const int tid = fresh_tid(wv), w = wv, lane = tid & 63, fr = lane & 15, g = lane >> 4, q4 = fr >> 2, p4 = fr & 3, wd = w >> 2, we = w & 3;
    const unsigned lbase = (unsigned)(uintptr_t)lds;
    LAS float* ssqL = (LAS float*)(lds + O_SSQ);
    LAS float* dcL = (LAS float*)(lds + O_SSQ + 512);
    f32x4 S[NDT];
    if (it.s_in) {
        const GAS float* sp = it.s_in + (size_t)(wd * DH + 4 * g) * it.sd + (size_t)(16 * we + fr) * it.se;
        if constexpr (MODE) {
#pragma unroll
            for (int dt = 0; dt < NDT; ++dt) S[dt] = *(const GAS f32x4*)(sp + 16 * dt);
        } else {
#pragma unroll
            for (int dt = 0; dt < NDT; ++dt)
#pragma unroll
                for (int r = 0; r < 4; ++r) S[dt][r] = sp[(size_t)(16 * dt + r) * it.sd];
        }
    } else {
#pragma unroll
        for (int dt = 0; dt < NDT; ++dt) S[dt] = (f32x4){0.f, 0.f, 0.f, 0.f};
    }
    if (tid < 128) ssqL[tid] = 0.f;
    const unsigned voq = (unsigned)((tid / CPR) * it.ldq + (tid % CPR) * 8) * 2u;
    const unsigned vov = (unsigned)((tid >> 3) * it.ldv + (tid & 7) * 8) * 2u;
    const unsigned vog = (unsigned)((16 * 2 * wd + fr) * it.ldg + 16 * we + 4 * g) * 2u;
    const int d0p = ((tid % CPR) * 8) & 31;
    const unsigned lq = (unsigned)((tid / CPR) * RSQ + ((((tid % CPR) * 8) & ~31) + 8 * ((d0p & 15) >> 2) + 4 * (d0p >> 4)) * 2), lv = (unsigned)((tid >> 3) * RSV + (tid & 7) * 16);
    const unsigned kbase = lbase + O_KI + (8 * g + q4) * RSQ + (wd * DH + 8 * p4) * 2;
    const unsigned vsbase = lbase + O_VS + (8 * g + q4) * RSV + (16 * we + 4 * p4) * 2;
    const unsigned vibase = lbase + O_VI + (32 * wd + 8 * g + q4) * RSV + (16 * we + 4 * p4) * 2;
    u32x4 pq[NQC], pk_[NQC], pv; float pdt = 0.f;
#define SCAN_ISSUE(sidx) do { const size_t rbi = (size_t)it.rowbase + 64 * (sidx); \
        const GAS char* qb_ = (const GAS char*)(it.qg + rbi * it.ldq); const GAS char* kb_ = (const GAS char*)(it.kg + rbi * it.ldq); \
        _Pragma("unroll") for (int r = 0; r < NQC; ++r) { \
            pq[r] = *(const GAS u32x4*)(qb_ + (size_t)r * (512 / CPR) * it.ldq * 2 + voq); pk_[r] = *(const GAS u32x4*)(kb_ + (size_t)r * (512 / CPR) * it.ldq * 2 + voq); } \
        pv = *(const GAS u32x4*)((const GAS char*)(it.vg + rbi * it.ldv) + vov); \
        if (MODE) pdt = it.dtg[(rbi + lane) * 64]; } while (0)
    SCAN_ISSUE(0);
    for (int s = 0; s < it.nsteps; ++s) {
        const size_t rb = (size_t)it.rowbase + 64 * s; const int par = s & 1;
        float dtv = 0.f, cum = 0.f, cum63 = 0.f;
        if (MODE) { dtv = pdt; cum = dtv * it.Ah;
            cum = wave_scan_incl(cum);
            cum63 = __builtin_bit_cast(float, __builtin_amdgcn_readlane(__builtin_bit_cast(int, cum), 63));
            if (w == 0) { dcL[lane] = cum; dcL[64 + lane] = dtv; } }
        const size_t rbn = (size_t)it.rowbase + 64 * ((s + 1 < it.nsteps) ? s + 1 : s);
        { const GAS char* qn_ = (const GAS char*)(it.qg + rbn * it.ldq); const GAS char* kn_ = (const GAS char*)(it.kg + rbn * it.ldq);
#pragma unroll
          for (int r = 0; r < NQC; ++r) {
            *(LAS u32x2*)(lds + O_QI + r * (512 / CPR) * RSQ + lq) = (u32x2){pq[r].x, pq[r].y}; *(LAS u32x2*)(lds + O_QI + r * (512 / CPR) * RSQ + lq + 16) = (u32x2){pq[r].z, pq[r].w};
            pq[r] = *(const GAS u32x4*)(qn_ + (size_t)r * (512 / CPR) * it.ldq * 2 + voq);
            *(LAS u32x2*)(lds + O_KI + r * (512 / CPR) * RSQ + lq) = (u32x2){pk_[r].x, pk_[r].y}; *(LAS u32x2*)(lds + O_KI + r * (512 / CPR) * RSQ + lq + 16) = (u32x2){pk_[r].z, pk_[r].w};
            pk_[r] = *(const GAS u32x4*)(kn_ + (size_t)r * (512 / CPR) * it.ldq * 2 + voq);
            __builtin_amdgcn_sched_barrier(0); } }
        const u32x4 pvc = pv;
        { *(LAS u32x4*)(lds + O_VI + lv) = pv;
          pv = *(const GAS u32x4*)((const GAS char*)(it.vg + rbn * it.ldv) + vov);
          if (MODE) pdt = it.dtg[(rbn + lane) * 64]; }
        u32x2 pg0, pg1;
        { const GAS char* gb_ = (const GAS char*)(it.gg + rb * it.ldg); pg0 = *(const GAS u32x2*)(gb_ + vog); pg1 = *(const GAS u32x2*)(gb_ + (size_t)16 * it.ldg * 2 + vog); }
        __syncthreads();
        if (w == 0 && s > 0) { const float v = ssqL[(par ^ 1) * 64 + lane]; ssqL[(par ^ 1) * 64 + lane] = 0.f;
            (void)__hip_atomic_fetch_add(it.ssqg + (rb - 64 + lane) * 8 + it.ssq_col, v, __ATOMIC_RELAXED, __HIP_MEMORY_SCOPE_AGENT); }
        { const int j = tid >> 3; float cd;
          if (MODE) cd = dcL[64 + j] * fast_exp(cum63 - dcL[j]); else cd = __builtin_amdgcn_exp2f(it.lg2 * (float)(63 - j));
          u32x4 sv; sv.x = cvt_pk_bf16(bf_lo(pvc.x) * cd, bf_hi(pvc.x) * cd); sv.y = cvt_pk_bf16(bf_lo(pvc.y) * cd, bf_hi(pvc.y) * cd);
          sv.z = cvt_pk_bf16(bf_lo(pvc.z) * cd, bf_hi(pvc.z) * cd); sv.w = cvt_pk_bf16(bf_lo(pvc.w) * cd, bf_hi(pvc.w) * cd);
          *(LAS u32x4*)(lds + O_VS + lv) = sv; }
        { const int jb = w & 3;
          f32x4 a2[2] = {(f32x4){0.f, 0.f, 0.f, 0.f}, (f32x4){0.f, 0.f, 0.f, 0.f}};
#pragma unroll
          for (int kk = 0; kk < NK1; ++kk) { const bf16x8 ka = *(const LAS bf16x8*)(lds + O_KI + (16 * jb + fr) * RSQ + (32 * kk + 8 * g) * 2);
#pragma unroll
              for (int ibi = 0; ibi < 2; ++ibi) { const bf16x8 qb = *(const LAS bf16x8*)(lds + O_QI + (16 * ((w >> 2) * 2 + ibi) + fr) * RSQ + (32 * kk + 8 * g) * 2);
                  a2[ibi] = __builtin_amdgcn_mfma_f32_16x16x32_bf16(ka, qb, a2[ibi], 0, 0, 0); } }
#pragma unroll
          for (int ibi = 0; ibi < 2; ++ibi) { const int ib = (w >> 2) * 2 + ibi; f32x4 a = a2[ibi];
            const int i = 16 * ib + fr, j0 = 16 * jb + 4 * g;
            if (MODE) { const float ci = dcL[i]; const f32x4 cj4 = *(const LAS f32x4*)(dcL + j0), dj4 = *(const LAS f32x4*)(dcL + 64 + j0);
#pragma unroll
                for (int r = 0; r < 4; ++r) { a[r] = (j0 + r <= i) ? a[r] * fast_exp(ci - cj4[r]) * dj4[r] : 0.f; } }
            else {
#pragma unroll
                for (int r = 0; r < 4; ++r) { const int df = i - (j0 + r); a[r] *= __builtin_amdgcn_exp2f(it.lg2 * (float)(df < 0 ? -df : df)); } }
            u32x2 pk; pk.x = cvt_pk_bf16(a[0], a[1]); pk.y = cvt_pk_bf16(a[2], a[3]);
            *(LAS u32x2*)(lds + O_PI + i * RSV + j0 * 2) = pk; } }
        __syncthreads();
        f32x4 O[4];
#pragma unroll
        for (int t = 0; t < 4; ++t) O[t] = (f32x4){0.f, 0.f, 0.f, 0.f};
#pragma unroll
        for (int kk = 0; kk < NK3; ++kk) {
            u32x4 sp; sp.x = cvt_pk_bf16(S[2 * kk][0], S[2 * kk][1]); sp.y = cvt_pk_bf16(S[2 * kk][2], S[2 * kk][3]); sp.z = cvt_pk_bf16(S[2 * kk + 1][0], S[2 * kk + 1][1]); sp.w = cvt_pk_bf16(S[2 * kk + 1][2], S[2 * kk + 1][3]);
            const bf16x8 sa = __builtin_bit_cast(bf16x8, sp);
#pragma unroll
            for (int t = 0; t < 4; ++t) { const bf16x8 qb = *(const LAS bf16x8*)(lds + O_QI + (16 * t + fr) * RSQ + (wd * DH + 32 * kk + 8 * g) * 2);
                O[t] = __builtin_amdgcn_mfma_f32_16x16x32_bf16(sa, qb, O[t], 0, 0, 0); } }
#pragma unroll
        for (int t = 0; t < 4; ++t) { const int i = 16 * t + fr; float rd;
            if (MODE) rd = fast_exp(dcL[i]); else rd = __builtin_amdgcn_exp2f(it.lg2 * (float)(i + 1));
            O[t] = O[t] * rd; }
        { const bf16x8 vt = tr_frag_i<0, 4 * RSV>(vibase);
#pragma unroll
          for (int t = 0; t < 4; ++t) { const bf16x8 pb = *(const LAS bf16x8*)(lds + O_PI + (16 * t + fr) * RSV + (32 * wd + 8 * g) * 2);
              O[t] = __builtin_amdgcn_mfma_f32_16x16x32_bf16(vt, pb, O[t], 0, 0, 0); } }
        f32x4 m0, m1;
        { const f32x4 x0 = wd ? O[0] : O[2], x1 = wd ? O[1] : O[3]; m0 = wd ? O[2] : O[0]; m1 = wd ? O[3] : O[1];
          *(LAS f32x4*)(lds + O_XC + ((w * 2 + 0) * 64 + lane) * 16) = x0;
          *(LAS f32x4*)(lds + O_XC + ((w * 2 + 1) * 64 + lane) * 16) = x1; }
        { const float cf = MODE ? fast_exp(cum63) : __builtin_amdgcn_exp2f(it.lg2 * 64.0f);
#pragma unroll
          for (int dt = 0; dt < NDT; ++dt) S[dt] = S[dt] * cf;
#define S4_QUAD(d0, kk) { constexpr int B_ = 32 * (kk) * RSQ + 32 * (d0);   \
              const bf16x8 k0_ = tr_frag_i<B_, B_ + 4 * RSQ>(kbase), k1_ = tr_frag_i<B_ + 8, B_ + 8 + 4 * RSQ>(kbase), k2_ = tr_frag_i<B_ + 64, B_ + 64 + 4 * RSQ>(kbase), k3_ = tr_frag_i<B_ + 72, B_ + 72 + 4 * RSQ>(kbase); \
              S[(d0) + 0] = __builtin_amdgcn_mfma_f32_16x16x32_bf16(k0_, vs, S[(d0) + 0], 0, 0, 0); S[(d0) + 1] = __builtin_amdgcn_mfma_f32_16x16x32_bf16(k1_, vs, S[(d0) + 1], 0, 0, 0); \
              S[(d0) + 2] = __builtin_amdgcn_mfma_f32_16x16x32_bf16(k2_, vs, S[(d0) + 2], 0, 0, 0); S[(d0) + 3] = __builtin_amdgcn_mfma_f32_16x16x32_bf16(k3_, vs, S[(d0) + 3], 0, 0, 0); }
#define S4_STEP(kk) { const bf16x8 vs = tr_frag_i<32 * (kk) * RSV, (32 * (kk) + 4) * RSV>(vsbase); S4_QUAD(0, kk) \
              if constexpr (NDT == 8) { S4_QUAD(4, kk) } }
          S4_STEP(0) S4_STEP(1)
#undef S4_STEP
#undef S4_QUAD
        }
        u32x2 xpre0 = {0u, 0u}, xpre1 = {0u, 0u};
        if (MODE) { xpre0 = *(const LAS u32x2*)(lds + O_VI + (16 * (2 * wd) + fr) * RSV + (16 * we + 4 * g) * 2); xpre1 = *(const LAS u32x2*)(lds + O_VI + (16 * (2 * wd + 1) + fr) * RSV + (16 * we + 4 * g) * 2); }
        __syncthreads();
#pragma unroll
        for (int t = 0; t < 2; ++t) {
            const f32x4 xin = *(const LAS f32x4*)(lds + O_XC + (((w ^ 4) * 2 + t) * 64 + lane) * 16);
            f32x4 o = (t ? m1 : m0) + xin; const int i = 16 * (2 * wd + t) + fr, e0 = 16 * we + 4 * g;
            const u32x2 pgt = t ? pg1 : pg0;
            const f32x4 gv = (f32x4){bf_lo(pgt.x), bf_hi(pgt.x), bf_lo(pgt.y), bf_hi(pgt.y)};
            float sq;
            if (MODE) { const u32x2 xw = t ? xpre1 : xpre0;
                const f32x4 xs = (f32x4){bf_lo(xw.x), bf_hi(xw.x), bf_lo(xw.y), bf_hi(xw.y)};
                o = (o + xs * it.Dh) * gv; sq = (o[0] * o[0] + o[1] * o[1]) + (o[2] * o[2] + o[3] * o[3]); }
            else { sq = (o[0] * o[0] + o[1] * o[1]) + (o[2] * o[2] + o[3] * o[3]); o = o * gv; }
            u32x2 pk; pk.x = cvt_pk_bf16(o[0], o[1]); pk.y = cvt_pk_bf16(o[2], o[3]);
            *(GAS u32x2*)((GAS char*)(it.yg + rb * it.ldg) + (size_t)t * 16 * it.ldg * 2 + vog) = pk;
            sq = rows_sum4(sq);
            if (g == 0) __hip_atomic_fetch_add(ssqL + par * 64 + i, sq, __ATOMIC_RELAXED, __HIP_MEMORY_SCOPE_WORKGROUP);
        }
    }
    __syncthreads();
    if (w == 0) { const int pl = (it.nsteps - 1) & 1; const float v = ssqL[pl * 64 + lane]; ssqL[pl * 64 + lane] = 0.f;
        (void)__hip_atomic_fetch_add(it.ssqg + ((size_t)it.rowbase + 64 * (it.nsteps - 1) + lane) * 8 + it.ssq_col, v, __ATOMIC_RELAXED, __HIP_MEMORY_SCOPE_AGENT); }
#undef SCAN_ISSUE
    if constexpr (MODE) {
#pragma unroll
        for (int dt = 0; dt < NDT; ++dt) *(GAS f32x4*)(it.s_out + (size_t)(wd * DH + 16 * dt + 4 * g) + (size_t)(16 * we + fr) * it.se) = S[dt];
    } else {
#pragma unroll
        for (int dt = 0; dt < NDT; ++dt)
#pragma unroll
            for (int r = 0; r < 4; ++r) { const int d = wd * DH + 16 * dt + 4 * g + r, e = 16 * we + fr; it.s_out[(size_t)d * it.sd + (size_t)e * it.se] = S[dt][r]; }
    }
    __syncthreads();
}

#define XB_TMO      128
#define XB_XCNT(j)  (256  + 64 * (j))
#define XB_XSUB(j)  (1280 + 64 * (j))
#define XB_XGEN(j)  (2304 + 64 * (j))
#define XB_TOP      3328
#define XB_TOPGEN   3392
#define XCD_BAR_WORDS 3456
#define XB_SPIN_CAP (1u << 22)
__device__ __forceinline__ unsigned xb_ld(unsigned* p)              { return __hip_atomic_load(p, __ATOMIC_RELAXED, __HIP_MEMORY_SCOPE_AGENT); }
__device__ __forceinline__ unsigned xb_add(unsigned* p, unsigned v) { return __hip_atomic_fetch_add(p, v, __ATOMIC_RELAXED, __HIP_MEMORY_SCOPE_AGENT); }
__device__ __forceinline__ unsigned xb_xcc_id() { return (unsigned)__builtin_amdgcn_s_getreg((3 << 11) | 20) & 0xFu; }
#define XB_SPIN(cond, bar) do { unsigned _sp = 0; while (cond) { __builtin_amdgcn_s_sleep(1); \
    if ((++_sp & 255u) == 0u) { if (xb_ld(&(bar)[XB_TMO])) break; if (_sp > XB_SPIN_CAP) { atomicAdd(&(bar)[XB_TMO], 1u); break; } } } } while (0)
struct XcdBarrier { unsigned* bar; unsigned x; volatile LAS unsigned* st; };
__device__ __forceinline__ XcdBarrier xcd_barrier_post(unsigned* bar, volatile LAS unsigned* st, const int wv) {
    XcdBarrier b; b.bar = bar; b.x = xb_xcc_id(); b.st = st;
    if (fresh_tid(wv) == 0) (void)xb_add(&bar[XB_XCNT(b.x)], 1u);
    return b;
}
__device__ __forceinline__ void xcd_barrier_complete(unsigned* bar, unsigned x, unsigned& nloc, unsigned& nx) {
    const unsigned G = gridDim.x * gridDim.y * gridDim.z;
    unsigned sum, cnt, mine, sp = 0u;
    for (;;) {
        sum = 0u; cnt = 0u; mine = 0u;
#pragma unroll
        for (unsigned j = 0; j < 16; ++j) { const unsigned c = xb_ld(&bar[XB_XCNT(j)]); sum += c; cnt += (c > 0u) ? 1u : 0u; mine = (j == x) ? c : mine; }
        if (sum == G) break;
        __builtin_amdgcn_s_sleep(1);
        if ((++sp & 255u) == 0u) { if (xb_ld(&bar[XB_TMO])) break; if (sp > XB_SPIN_CAP) { atomicAdd(&bar[XB_TMO], 1u); break; } }
    }
    nloc = mine > 0u ? mine : 1u; nx = cnt > 0u ? cnt : 1u;
}
__device__ __forceinline__ void xcd_barrier(const XcdBarrier& b, const int wv) {
    asm volatile("s_waitcnt vmcnt(0)" ::: "memory");
    __syncthreads();
    if (fresh_tid(wv) == 0) {
        unsigned* bar = b.bar;
        __builtin_amdgcn_s_waitcnt(0);
        unsigned nloc = b.st[0], nx = b.st[1];
        if (nloc == 0u) { xcd_barrier_complete(bar, b.x, nloc, nx); b.st[0] = nloc; b.st[1] = nx; }
        const unsigned old = xb_add(&bar[XB_XSUB(b.x)], 1u);
        const unsigned gen = old / nloc;
        if (old + 1u == (gen + 1u) * nloc) {
            __builtin_amdgcn_fence(__ATOMIC_RELEASE, "agent");
            asm volatile("s_waitcnt vmcnt(0)" ::: "memory");
            const unsigned og = xb_add(&bar[XB_TOP], 1u);
            const unsigned tg = og / nx;
            if (og + 1u == (tg + 1u) * nx) xb_add(&bar[XB_TOPGEN], 1u);
            else XB_SPIN(xb_ld(&bar[XB_TOPGEN]) == tg, bar);
            __builtin_amdgcn_fence(__ATOMIC_ACQUIRE, "agent");
            xb_add(&bar[XB_XGEN(b.x)], 1u);
            asm volatile("s_waitcnt vmcnt(0)" ::: "memory");
        } else {
            XB_SPIN(xb_ld(&bar[XB_XGEN(b.x)]) == gen, bar);
            __builtin_amdgcn_fence(__ATOMIC_ACQUIRE, "agent");
            asm volatile("s_waitcnt vmcnt(0)" ::: "memory");
        }
    }
    __syncthreads();
}

__device__ __forceinline__ void wt_item(const GAS float* W, int K, int N, GAS bf16* Wt, const GAS float* lnw, int mode, LAS float* scr, int item, int lane) {
    const int nblk = N >> 6, kb = item / nblk, nb = item - kb * nblk, k0 = kb << 6, n0 = nb << 6;
    { f32x4 v[16]; float lw[16];
      const int c = 4 * (lane & 15); const GAS float* wp = W + (size_t)(k0 + (lane >> 4)) * N + n0 + c;
#pragma unroll
      for (int i = 0; i < 16; ++i) { v[i] = *(const GAS f32x4*)(wp + (size_t)(4 * i) * N); lw[i] = lnw ? lnw[k0 + (lane >> 4) + 4 * i] : 1.0f; }
#pragma unroll
      for (int i = 0; i < 16; ++i) { const int kk = (lane >> 4) + 4 * i; const f32x4 t = v[i] * lw[i];
        scr[kk * 65 + c] = t[0]; scr[kk * 65 + c + 1] = t[1]; scr[kk * 65 + c + 2] = t[2]; scr[kk * 65 + c + 3] = t[3]; } }
    LDS_WAIT(); asm volatile("" ::: "memory");
    const int c8 = lane & 7;
#pragma unroll
    for (int i = 0; i < 8; ++i) { const int n = (lane >> 3) + 8 * i; const LAS float* s = scr + (8 * c8) * 65 + n;
        u32x4 o; o.x = cvt_pk_bf16(s[0], s[65]); o.y = cvt_pk_bf16(s[130], s[195]); o.z = cvt_pk_bf16(s[260], s[325]); o.w = cvt_pk_bf16(s[390], s[455]);
        const int nn = n0 + n; const int drow = mode == 0 ? nn : (256 * (nn >> 7) + (nn & 127) + (mode == 2 ? 128 : 0));
        *(GAS u32x4*)(Wt + (size_t)drow * (K + WPAD) + k0 + 8 * c8) = o; }
    LDS_WAIT(); asm volatile("" ::: "memory");
}

#define INP(k) ((const GAS float*)args.in[k])
struct Args {
    const float* in[21]; float* out; unsigned char* ws;
    int ph_lo, ph_hi;
    float lg2[8];
    float pad0, pad1;
    double invrev[128];
};

__global__ void __launch_bounds__(NWAVES * 64, 2) mega_fwd(Args args) {
    extern __shared__ __attribute__((aligned(16))) unsigned char lds_raw[];
    LAS unsigned char* lds = (LAS unsigned char*)lds_raw;
    volatile LAS unsigned* MISC = (volatile LAS unsigned*)(lds + MISC_OFF);
    const int wv = __builtin_amdgcn_readfirstlane(threadIdx.x >> 6);
    const int G = gridDim.x, bx = blockIdx.x, vcu = (G % 8 == 0) ? (bx % 8) * (G / 8) + bx / 8 : bx;
    gu32* ctl = (gu32*)(args.ws + WS_CTL);
    for (int u = fresh_tid(wv); u < (LDS_BYTES - MISC_OFF) / 4; u += NWAVES * 64) ((LAS unsigned*)(lds + MISC_OFF))[u] = 0u;
    __syncthreads();
    if (!MK_PER_PHASE) (void)xcd_barrier_post((unsigned*)ctl + 4096, MISC + 8, wv);
    const int lo = args.ph_lo, hi = args.ph_hi;
#ifndef PH_MASK
#define PH_MASK 0x1fff
#endif
#define IN(k) (((PH_MASK >> (k)) & 1) && lo <= (k) && (k) < hi)
#define SEAM(k) do { if (!MK_PER_PHASE && IN(k) && IN((k) + 1)) { XcdBarrier b_; b_.bar = (unsigned*)(args.ws + WS_CTL) + 4096; b_.x = xb_xcc_id(); b_.st = (volatile LAS unsigned*)(lds + MISC_OFF) + 8; xcd_barrier(b_, wv); } } while (0)
    const int NGW = G * NWAVES;
#define SEAM_COUNT(cntp) do { gu32* cp_ = (cntp); asm volatile("s_waitcnt vmcnt(0)" ::: "memory"); __syncthreads(); \
        if (fresh_tid(wv) == 0) { if (bx < G - 16) { __builtin_amdgcn_fence(__ATOMIC_RELEASE, "agent"); asm volatile("s_waitcnt vmcnt(0)" ::: "memory"); (void)__hip_atomic_fetch_add(cp_, 8u, __ATOMIC_RELAXED, __HIP_MEMORY_SCOPE_AGENT); } \
            pg8::wait_count(cp_, (unsigned)G * 8u); asm volatile("s_waitcnt vmcnt(0)" ::: "memory"); } \
        __syncthreads(); } while (0)
#define PHASE_IDS() const int tid = fresh_tid(wv), lane = tid & 63, wave = wv, gw = vcu * NWAVES + wave; (void)lane; (void)gw
#define PHASE_PTRS() GAS unsigned char* ws = (GAS unsigned char*)args.ws; GAS float* out = (GAS float*)args.out; asm volatile("" : "+s"(ws), "+s"(out)); (void)out; \
    GAS float* X = (GAS float*)(ws + WS_X); GAS bf16* XB = (GAS bf16*)(ws + WS_XB); GAS float* SSQ = (GAS float*)(ws + OFF_SSQ); GAS float* SSQR = (GAS float*)(ws + OFF_SSQR); GAS float* SSQS = (GAS float*)(ws + OFF_SSQS); \
    GAS float* COS = (GAS float*)(ws + WS_COS); GAS float* SIN = (GAS float*)(ws + WS_SIN); GAS float* DT = (GAS float*)(ws + WS_DT); (void)X; (void)XB; (void)SSQ; (void)SSQR; (void)SSQS; (void)COS; (void)SIN; (void)DT

#define WJOB(Wp, Kk, Nn, dstoff, lnwp, md) do { const int nitems = ((Kk) >> 6) * ((Nn) >> 6); int first = cw - (base % CNW); if (first < 0) first += CNW; \
        for (int itx = first; itx < nitems; itx += CNW) wt_item((Wp), (Kk), (Nn), (GAS bf16*)(ws + (dstoff)), (lnwp), (md), scr, itx, lane); base += nitems; } while (0)
#define CONV_RET() do { WJOB(INP(8), DM, RET_IN, W_RIN, INP(5), 0); WJOB(INP(9), VDIM, DM, W_ROUT, (const GAS float*)nullptr, 0); } while (0)
#define CONV_FFN0() do { WJOB(INP(18), DM, FF, W_F0GU, INP(6), 1); WJOB(INP(19), DM, FF, W_F0GU, INP(6), 2); WJOB(INP(20), FF, DM, W_F0D, (const GAS float*)nullptr, 0); } while (0)
#define CONV_L1A() do { WJOB(INP(10), DM, SSD_IN, W_SIN, INP(5) + DM, 0); \
        { GAS u32x4* p = (GAS u32x4*)(ws + W_SIN + (size_t)SSD_IN * (DM + WPAD) * 2); const int n16 = (SSD_INP - SSD_IN) * (DM + WPAD) * 2 / 16; \
          for (int i = cw * 64 + lane; i < n16; i += CNW * 64) p[i] = (u32x4){0u, 0u, 0u, 0u}; } } while (0)
#define CONV_L1B() do { WJOB(INP(17), VDIM, DM, W_SOUT, INP(16), 0); \
        WJOB(INP(18) + (size_t)DM * FF, DM, FF, W_F1GU, INP(6) + DM, 1); WJOB(INP(19) + (size_t)DM * FF, DM, FF, W_F1GU, INP(6) + DM, 2); WJOB(INP(20) + (size_t)FF * DM, FF, DM, W_F1D, (const GAS float*)nullptr, 0); } while (0)
    if (IN(0)) {
        PHASE_PTRS();
        PHASE_IDS();
        LAS float* scr = (LAS float*)(lds + wave * 16640);
        { const int cw = gw, CNW = NGW; int base = 0; CONV_RET(); (void)base; }
        {
            f32x4 vn[8]; int m = gw;
            if (m < MROWS) { const GAS float* xr = m < MP ? INP(0) + (size_t)m * DM : INP(1) + (size_t)(m - MP) * DM;
#pragma unroll
                for (int j = 0; j < 8; ++j) vn[j] = *(const GAS f32x4*)(xr + 256 * j + 4 * lane); }
            for (; m < MROWS; m += NGW) {
                f32x4 vc[8];
#pragma unroll
                for (int j = 0; j < 8; ++j) vc[j] = vn[j];
                const int m2 = m + NGW;
                if (m2 < MROWS) { const GAS float* xr = m2 < MP ? INP(0) + (size_t)m2 * DM : INP(1) + (size_t)(m2 - MP) * DM;
#pragma unroll
                    for (int j = 0; j < 8; ++j) vn[j] = *(const GAS f32x4*)(xr + 256 * j + 4 * lane); }
                float s = 0.f;
#pragma unroll
                for (int j = 0; j < 8; ++j) { const f32x4 v = vc[j];
                    u32x2 pw; pw.x = cvt_pk_bf16(v[0], v[1]); pw.y = cvt_pk_bf16(v[2], v[3]);
                    *(GAS u32x2*)(XB + (size_t)m * DM + 256 * j + 4 * lane) = pw; s += (v[0] * v[0] + v[1] * v[1]) + (v[2] * v[2] + v[3] * v[3]); }
                s = wave_sum(s); if (lane == 0) SSQ[m] = s;
            }
        }
        __syncthreads();
    }
    SEAM(0);

    if (IN(1)) {
        PHASE_PTRS();
        pg8::Gemm g{XB, (const GAS bf16*)(ws + W_RIN), MROWS, RET_IN, DM}; pg8::StaticOrder S; S.init(32 * 256, RET_IN, G, bx);
        EpiRetIn E{(LAS float*)(lds + pg8::STAGE_BYTES + 4096), (GAS bf16*)(ws + SC_Q), (GAS bf16*)(ws + SC_K), (GAS bf16*)(ws + SC_V), (GAS bf16*)(ws + SC_G), SSQ, (const GAS double*)args.invrev};
        pg8::gemm_phase<EpiRetIn, pg8::StaticOrder>(lds, g, S, E, wv);
    }
    SEAM(1);

    if (IN(2)) {
        PHASE_PTRS();
        for (int c = vcu; c < 768; c += G) {
            ScanItem it; const bool smp = c >= 256; const int cc = smp ? c - 256 : c; const int b = cc >> 6, h = (cc >> 3) & 7, sl = cc & 7;
            it.qg = (const GAS bf16*)(ws + SC_Q) + h * 256; it.kg = (const GAS bf16*)(ws + SC_K) + h * 256; it.vg = (const GAS bf16*)(ws + SC_V) + h * 512 + sl * 64; it.ldq = DM; it.ldv = VDIM;
            it.gg = (const GAS bf16*)(ws + SC_G) + h * 512 + sl * 64; it.yg = (GAS bf16*)(ws + SC_V) + h * 512 + sl * 64; it.ldg = VDIM;
            it.ssqg = SSQR; it.ssq_col = h; it.rowbase = smp ? MP + b * 64 : b * 2048; it.nsteps = smp ? 1 : 32;
            const size_t so = ((size_t)(b * 8 + h) * 256) * 512 + sl * 64;
            it.s_in = smp ? INP(2) + so : nullptr; it.s_out = out + (smp ? OUT_RETS : OUT_RETP) + so; it.sd = 512; it.se = 1;
            it.lg2 = args.lg2[h]; it.dtg = nullptr; it.Ah = 0.f; it.Dh = 0.f;
            scan_chain<0>(lds, it, wv);
        }
    }
    SEAM(2);

    if (IN(3)) {
        PHASE_PTRS();
        pg8::Gemm g{(const GAS bf16*)(ws + SC_V), (const GAS bf16*)(ws + W_ROUT), MROWS, DM, VDIM}; pg8::StaticOrder S; S.init(32 * 256, DM, G, bx);
        EpiResid<true, true> E{XB, SSQ + 1 * MROWS, SSQR, nullptr, nullptr};
        pg8::gemm_phase<EpiResid<true, true>, pg8::StaticOrder>(lds, g, S, E, wv);
        { PHASE_IDS(); LAS float* scr = (LAS float*)(lds + wave * 16640); const int cw = gw, CNW = NGW; int base = 0; CONV_FFN0(); (void)base; __syncthreads(); }
    }
    SEAM(3);
    if (IN(4)) {
        PHASE_PTRS();
        pg8::Gemm g{XB, (const GAS bf16*)(ws + W_F0GU), MROWS, FF2, DM}; pg8::StaticOrder S; S.init(MROWS, FF2, G, bx);
        EpiFfnGU E{(GAS bf16*)(ws + SC_H), SSQ + 1 * MROWS};
        pg8::gemm_phase<EpiFfnGU, pg8::StaticOrder>(lds, g, S, E, wv);
    }
    SEAM(4);
    if (IN(5)) {
        PHASE_PTRS();
        pg8::Gemm g{(const GAS bf16*)(ws + SC_H), (const GAS bf16*)(ws + W_F0D), MROWS, DM, FF}; pg8::StaticOrder S; S.init(32 * 256, DM, G, bx);
        EpiResid<false, true> E{XB, SSQ + 2 * MROWS, nullptr, nullptr, nullptr};
        pg8::gemm_phase<EpiResid<false, true>, pg8::StaticOrder>(lds, g, S, E, wv);
        { PHASE_IDS(); LAS float* scr = (LAS float*)(lds + wave * 16640); const int cw = gw, CNW = NGW; int base = 0; CONV_L1A(); if (G != 256) CONV_L1B(); (void)base; __syncthreads(); }
    }
    SEAM(5);
    if (IN(6)) {
        PHASE_PTRS();
        const int NG6 = (G == 256) ? 233 : G;
        if (bx < NG6) {
            pg8::Gemm g{XB, (const GAS bf16*)(ws + W_SIN), MROWS, SSD_INP, DM}; pg8::StaticOrder S; S.init(MROWS, SSD_INP, NG6, bx);
            EpiSsdIn E{(GAS bf16*)(ws + SC_Z), (GAS bf16*)(ws + SC_XBC), DT, SSQ + 2 * MROWS, INP(13), out + OUT_CONVP, out + OUT_CONVS};
            pg8::gemm_phase<EpiSsdIn, pg8::StaticOrder>(lds, g, S, E, wv);
        } else { PHASE_IDS(); LAS float* scr = (LAS float*)(lds + wave * 16640); const int cw = (bx - NG6) * NWAVES + wave, CNW = (G - NG6) * NWAVES; int base = 0; CONV_L1B(); (void)base; __syncthreads(); }
    }
    SEAM(6);
    if (IN(7)) {
        PHASE_PTRS();
        PHASE_IDS();
        const GAS bf16* XBC = (const GAS bf16*)(ws + SC_XBC); GAS bf16* XC = (GAS bf16*)(ws + SC_XC);
        constexpr int RS = 64, NCH = CONVD / 8, NITEM = (MROWS / RS) * NCH;
        for (int item = (wave * G + vcu) * 64 + lane; item < NITEM; item += G * NWAVES * 64) {
            const int sg = item / NCH, c = (item - sg * NCH) * 8, r0 = sg * RS;
            f32x4 w[4][2], bs[2];
#pragma unroll
            for (int tau = 0; tau < 4; ++tau) { w[tau][0] = *(const GAS f32x4*)(INP(11) + tau * CONVD + c); w[tau][1] = *(const GAS f32x4*)(INP(11) + tau * CONVD + c + 4); }
            bs[0] = *(const GAS f32x4*)(INP(12) + c); bs[1] = *(const GAS f32x4*)(INP(12) + c + 4);
            const GAS bf16* src = XBC + (size_t)r0 * CONVD + c; GAS bf16* dst = XC + (size_t)r0 * CONVD + c;
            u32x4 xn[8];
#pragma unroll
            for (int i = 0; i < 8; ++i) xn[i] = *(const GAS u32x4*)(src + (size_t)i * CONVD);
            f32x4 h[3][2];
            const bool seq0 = r0 < MP ? (r0 & 2047) == 0 : ((r0 - MP) & 63) == 0;
            if (!seq0) {
#pragma unroll
                for (int k = 0; k < 3; ++k) { const u32x4 p = *(const GAS u32x4*)(src - (size_t)(3 - k) * CONVD);
                    h[k][0] = (f32x4){bf_lo(p.x), bf_hi(p.x), bf_lo(p.y), bf_hi(p.y)}; h[k][1] = (f32x4){bf_lo(p.z), bf_hi(p.z), bf_lo(p.w), bf_hi(p.w)}; }
            } else if (r0 >= MP) { const GAS float* c0p = INP(4) + (size_t)((r0 - MP) >> 6) * 3 * CONVD + c;
#pragma unroll
                for (int k = 0; k < 3; ++k) { h[k][0] = *(const GAS f32x4*)(c0p + (size_t)k * CONVD); h[k][1] = *(const GAS f32x4*)(c0p + (size_t)k * CONVD + 4); }
            } else {
#pragma unroll
                for (int k = 0; k < 3; ++k) { h[k][0] = (f32x4){0.f, 0.f, 0.f, 0.f}; h[k][1] = h[k][0]; }
            }
            for (int rb = 0; rb < RS; rb += 8) {
                u32x4 xc[8];
#pragma unroll
                for (int i = 0; i < 8; ++i) xc[i] = xn[i];
                if (rb + 8 < RS) {
#pragma unroll
                    for (int i = 0; i < 8; ++i) xn[i] = *(const GAS u32x4*)(src + (size_t)(rb + 8 + i) * CONVD);
                }
#pragma unroll
                for (int i = 0; i < 8; ++i) {
                    const f32x4 c0 = (f32x4){bf_lo(xc[i].x), bf_hi(xc[i].x), bf_lo(xc[i].y), bf_hi(xc[i].y)}, c1 = (f32x4){bf_lo(xc[i].z), bf_hi(xc[i].z), bf_lo(xc[i].w), bf_hi(xc[i].w)};
                    const f32x4 a0 = bs[0] + h[0][0] * w[0][0] + h[1][0] * w[1][0] + h[2][0] * w[2][0] + c0 * w[3][0];
                    const f32x4 a1 = bs[1] + h[0][1] * w[0][1] + h[1][1] * w[1][1] + h[2][1] * w[2][1] + c1 * w[3][1];
                    *(GAS u32x4*)(dst + (size_t)(rb + i) * CONVD) = pack8(silu4(a0), silu4(a1));
                    h[0][0] = h[1][0]; h[0][1] = h[1][1]; h[1][0] = h[2][0]; h[1][1] = h[2][1]; h[2][0] = c0; h[2][1] = c1;
                }
            }
        }
    }
    SEAM(7);
    if (IN(8)) {
        PHASE_PTRS();
        const GAS bf16* XC = (const GAS bf16*)(ws + SC_XC);
        for (int c = vcu; c < 768; c += G) {
            ScanItem it; const bool smp = c >= 256; const int cc = smp ? c - 256 : c; const int b = cc >> 6, head = cc & 63, grp = head >> 3;
            it.qg = XC + 5120 + grp * 128; it.kg = XC + 4096 + grp * 128; it.vg = XC + head * 64; it.ldq = CONVD; it.ldv = CONVD;
            it.gg = (const GAS bf16*)(ws + SC_Z) + head * 64; it.yg = (GAS bf16*)(ws + SC_Z) + head * 64; it.ldg = VDIM;
            it.ssqg = SSQS; it.ssq_col = grp; it.rowbase = smp ? MP + b * 64 : b * 2048; it.nsteps = smp ? 1 : 32;
            const size_t so = (size_t)(b * 64 + head) * 64 * 128;
            it.s_in = smp ? INP(3) + so : nullptr; it.s_out = out + (smp ? OUT_SSMS : OUT_SSMP) + so; it.sd = 1; it.se = 128;
            it.lg2 = 0.f; it.dtg = DT + head; it.Ah = -__expf(INP(14)[head]); it.Dh = INP(15)[head];
            scan_chain<1>(lds, it, wv);
        }
    }
    SEAM(8);
    if (IN(9)) {
        PHASE_PTRS();
        pg8::Gemm g{(const GAS bf16*)(ws + SC_Z), (const GAS bf16*)(ws + W_SOUT), MROWS, DM, VDIM}; pg8::StaticOrder S; S.init(32 * 256, DM, G, bx);
        EpiResid<true, true> E{XB, SSQ + 3 * MROWS, SSQS, nullptr, nullptr};
        pg8::gemm_phase<EpiResid<true, true>, pg8::StaticOrder>(lds, g, S, E, wv);
    }
    SEAM(9);
    if (IN(10)) {
        PHASE_PTRS();
        pg8::Gemm g{XB, (const GAS bf16*)(ws + W_F1GU), MROWS, FF2, DM}; pg8::StaticOrder S; S.init(MROWS, FF2, G, bx);
        EpiFfnGU E{(GAS bf16*)(ws + SC_H1), SSQ + 3 * MROWS};
        pg8::gemm_phase<EpiFfnGU, pg8::StaticOrder>(lds, g, S, E, wv);
    }
    SEAM(10);
    if (IN(11)) {
        PHASE_PTRS();
        pg8::Gemm g{(const GAS bf16*)(ws + SC_H1), (const GAS bf16*)(ws + W_F1D), MROWS, DM, FF}; pg8::StaticOrder S; S.init(32 * 256, DM, G, bx);
        if (G == 256 && !MK_PER_PHASE && IN(12)) {
            EpiFinal E{XB, SSQ + 4 * MROWS, INP(7), out + OUT_Y, (gu32*)(ws + SEAMCNT_OFF + 8192)};
            pg8::gemm_phase<EpiFinal, pg8::StaticOrder>(lds, g, S, E, wv);
        } else {
            EpiResid<false, true> E{XB, SSQ + 4 * MROWS, nullptr, nullptr, nullptr};
            pg8::gemm_phase<EpiResid<false, true>, pg8::StaticOrder>(lds, g, S, E, wv);
        }
    }
    if (!(G == 256 && !MK_PER_PHASE && IN(11) && IN(12))) {
    SEAM(11);
    if (IN(12)) {
        PHASE_PTRS();
        PHASE_IDS();
        for (int m = gw; m < MROWS; m += NGW) {
            const float rs = __builtin_amdgcn_rsqf(SSQ[4 * MROWS + m] * (1.0f / DM) + EPS);
#pragma unroll
            for (int j = 0; j < 8; ++j) { const u32x2 xw = *(const GAS u32x2*)(XB + (size_t)m * DM + 256 * j + 4 * lane); const f32x4 v = (f32x4){bf_lo(xw.x), bf_hi(xw.x), bf_lo(xw.y), bf_hi(xw.y)}, lw = *(const GAS f32x4*)(INP(7) + 256 * j + 4 * lane);
                *(GAS f32x4*)(out + OUT_Y + (size_t)m * DM + 256 * j + 4 * lane) = v * rs * lw; }
        }
    }
    }
#undef IN
#undef SEAM
}

extern "C" void kernel_launch(void* const* d_in, const int* in_sizes, int n_in, void* d_out, int out_size, void* d_ws, size_t ws_size, hipStream_t stream) {
    static int grid = 0;
    if (grid == 0) {
        if (n_in != 21 || out_size != (int)OUT_END || ws_size < WS_END) { fprintf(stderr, "kernel_launch: unexpected shapes (n_in %d out %d ws %zu, need ws >= %zu)\n", n_in, out_size, ws_size, (size_t)WS_END); grid = -1; return; }
        int dev = 0, cus = 0, per_cu = 0;
        if (hipGetDevice(&dev) != hipSuccess || hipDeviceGetAttribute(&cus, hipDeviceAttributeMultiprocessorCount, dev) != hipSuccess) { grid = -1; return; }
        if (hipFuncSetAttribute((const void*)mega_fwd, hipFuncAttributeMaxDynamicSharedMemorySize, LDS_BYTES) != hipSuccess) { fprintf(stderr, "kernel_launch: hipFuncSetAttribute failed\n"); grid = -1; return; }
        if (hipOccupancyMaxActiveBlocksPerMultiprocessor(&per_cu, (const void*)mega_fwd, NWAVES * 64, LDS_BYTES) != hipSuccess || per_cu < 1) { fprintf(stderr, "kernel_launch: occupancy query says %d blocks per CU\n", per_cu); per_cu = 1; }
        (void)hipGetLastError();
        grid = cus * (per_cu < 1 ? 1 : 1);
        if (grid % 8 != 0 || grid > 768) fprintf(stderr, "kernel_launch: note: grid %d\n", grid);
    }
    if (grid < 0) return;
    (void)hipMemsetAsync((char*)d_ws + WS_CTL, 0, CTL_BYTES, stream);
    Args a{};
    for (int i = 0; i < 21; ++i) a.in[i] = (const float*)d_in[i];
    a.out = (float*)d_out; a.ws = (unsigned char*)d_ws;
    for (int h = 0; h < 8; ++h) a.lg2[h] = (float)(log1p(-exp2(-5.0 - (double)h)) / log(2.0));
    for (int d = 0; d < 128; ++d) a.invrev[d] = pow(10000.0, -(double)d / 128.0) / (2.0 * M_PI);
#if MK_PER_PHASE
    for (int p = 0; p < 13; ++p) { a.ph_lo = p; a.ph_hi = p + 1; hipLaunchKernelGGL(mega_fwd, dim3(grid), dim3(NWAVES * 64), LDS_BYTES, stream, a); }
#else
    a.ph_lo = 0; a.ph_hi = 13;
    void* kargs[] = {&a};
    hipError_t e = hipLaunchCooperativeKernel((const void*)mega_fwd, dim3(grid), dim3(NWAVES * 64), kargs, LDS_BYTES, stream);
    if (e != hipSuccess) fprintf(stderr, "kernel_launch: cooperative launch failed: %s (grid %d)\n", hipGetErrorString(e), grid);
#endif
}
```

```cpp
#include <hip/hip_runtime.h>
#include <cstdio>
#include <cstdint>
#include <cmath>

#ifndef MK_PER_PHASE
#define MK_PER_PHASE 0
#endif

#define LAS __attribute__((address_space(3)))
#define GAS __attribute__((address_space(1)))
typedef unsigned short bf16;
typedef short bf16x8 __attribute__((ext_vector_type(8)));
typedef short s16x4 __attribute__((ext_vector_type(4)));
typedef float f32x4 __attribute__((ext_vector_type(4)));
typedef float f32x2 __attribute__((ext_vector_type(2)));
typedef unsigned u32x4 __attribute__((ext_vector_type(4)));
typedef unsigned u32x2 __attribute__((ext_vector_type(2)));
typedef GAS unsigned gu32;

constexpr int DM = 2048;
constexpr int MROWS = 8704;
constexpr int MP = 8192;
constexpr int RET_IN = 12288, VDIM = 4096, FF = 5632, FF2 = 11264;
constexpr int SSD_IN = 10304, SSD_INP = 10496, CONVD = 6144;
constexpr int NPOS = 2112;
constexpr float EPS = 1e-6f;

constexpr size_t MiB = 1u << 20;
constexpr size_t WS_CTL = 0, CTL_BYTES = 2 * MiB;
constexpr size_t OFF_SSQ = 65536;
constexpr size_t OFF_SSQR = 262144;
constexpr size_t OFF_SSQS = 589824;
constexpr size_t WS_COS = 2 * MiB, WS_SIN = WS_COS + (size_t)NPOS * 128 * 4;
constexpr size_t WS_DT = 5 * MiB;
constexpr size_t WS_W = 8 * MiB;
constexpr int WPAD = 128;
constexpr size_t W_RIN = WS_W, W_ROUT = W_RIN + 51 * MiB, W_F0GU = W_ROUT + 17 * MiB, W_F0D = W_F0GU + 47 * MiB;
constexpr size_t W_SIN = W_F0D + 23 * MiB, W_SOUT = W_SIN + 44 * MiB, W_F1GU = W_SOUT + 17 * MiB, W_F1D = W_F1GU + 47 * MiB;
constexpr size_t WS_X = W_F1D + 23 * MiB;
constexpr size_t WS_XB = WS_X + 68 * MiB;
constexpr size_t WS_SCR = WS_XB + 34 * MiB;
constexpr size_t SC_Q = WS_SCR, SC_K = SC_Q + 34 * MiB, SC_V = SC_K + 34 * MiB, SC_G = SC_V + 68 * MiB;
constexpr size_t SC_H = WS_SCR;
constexpr size_t SC_H1 = WS_SCR + 68 * MiB;
constexpr size_t SC_Z = WS_SCR, SC_XBC = SC_Z + 68 * MiB;
constexpr size_t SC_XC = WS_W;
constexpr size_t WS_END = SC_G + 68 * MiB;
constexpr size_t SEAMCNT_OFF = 1 * MiB;
static_assert(W_RIN + (size_t)RET_IN * (DM + WPAD) * 2 <= W_ROUT && W_ROUT + (size_t)DM * (VDIM + WPAD) * 2 <= W_F0GU && W_F0GU + (size_t)FF2 * (DM + WPAD) * 2 <= W_F0D && W_F0D + (size_t)DM * (FF + WPAD) * 2 <= W_SIN && W_SIN + (size_t)SSD_INP * (DM + WPAD) * 2 <= W_SOUT && W_SOUT + (size_t)DM * (VDIM + WPAD) * 2 <= W_F1GU && W_F1GU + (size_t)FF2 * (DM + WPAD) * 2 <= W_F1D && W_F1D + (size_t)DM * (FF + WPAD) * 2 <= WS_X, "weights map");
static_assert(SC_H1 + (size_t)MROWS * FF * 2 <= WS_END && SC_XC + (size_t)MROWS * CONVD * 2 <= W_SIN && SC_XBC + (size_t)MROWS * CONVD * 2 <= WS_END && SC_H + (size_t)MROWS * FF * 2 <= WS_END, "overlay map");
static_assert(WS_X + (size_t)MROWS * DM * 4 <= WS_XB && WS_XB + (size_t)MROWS * DM * 2 <= WS_SCR, "x map");
constexpr size_t OUT_Y = 0, OUT_RETP = 17825792, OUT_SSMP = 22020096, OUT_CONVP = 24117248, OUT_RETS = 24190976, OUT_SSMS = 32579584, OUT_CONVS = 36773888, OUT_END = 36921344;

constexpr int LDS_BYTES = 156672;
constexpr int MISC_OFF = 155648;
constexpr int NWAVES = 8;

#define RLX_AGENT __ATOMIC_RELAXED, __HIP_MEMORY_SCOPE_AGENT
#define LDS_WAIT() asm volatile("s_waitcnt lgkmcnt(0)" ::: "memory")
#define VM_WAIT() asm volatile("s_waitcnt vmcnt(0)" ::: "memory")

typedef __bf16 bf16x2_t __attribute__((ext_vector_type(2)));
__device__ __forceinline__ unsigned cvt_pk_bf16(float lo, float hi) { const float __attribute__((ext_vector_type(2))) v = {lo, hi}; const bf16x2_t b = __builtin_convertvector(v, bf16x2_t); return __builtin_bit_cast(unsigned, b); }
__device__ __forceinline__ float bf_lo(unsigned w) { return __uint_as_float(w << 16); }
__device__ __forceinline__ float bf_hi(unsigned w) { return __uint_as_float(w & 0xffff0000u); }
__device__ __forceinline__ float fast_exp(float x) { return __builtin_amdgcn_exp2f(x * 1.44269504089f); }
__device__ __forceinline__ float softplus_f(float x) { const float t = __builtin_amdgcn_exp2f(-__builtin_fabsf(x) * 1.44269504089f); return __builtin_fmaxf(x, 0.f) + __builtin_amdgcn_logf(1.0f + t) * 0.69314718056f; }
__device__ __forceinline__ float silu_f(float x) { return x * __builtin_amdgcn_rcpf(1.0f + fast_exp(-x)); }
__device__ __forceinline__ float wave_scan_incl(float x) {
#define WS_DPP(v_, ctrl_, rmask_) __builtin_bit_cast(float, __builtin_amdgcn_update_dpp(0, __builtin_bit_cast(int, (v_)), (ctrl_), (rmask_), 0xf, false))
    float v = x;
    v += WS_DPP(v, 0x111, 0xf);
    v += WS_DPP(v, 0x112, 0xf);
    v += WS_DPP(v, 0x114, 0xf);
    v += WS_DPP(v, 0x118, 0xf);
    v += WS_DPP(v, 0x142, 0xa);
    v += WS_DPP(v, 0x143, 0xc);
#undef WS_DPP
    return v;
}
__device__ __forceinline__ float rows_sum4(float x) {
    float a = x, b = x;
    asm volatile("s_nop 1\n\tv_permlane16_swap_b32 %0, %1\n\ts_nop 1" : "+v"(a), "+v"(b));
    float c = a + b, d = c;
    asm volatile("s_nop 1\n\tv_permlane32_swap_b32 %0, %1\n\ts_nop 1" : "+v"(c), "+v"(d));
    return c + d;
}
__device__ __forceinline__ float wave_sum(float v) {
#pragma unroll
    for (int o = 1; o < 64; o <<= 1) v += __shfl_xor(v, o);
    return v;
}

__device__ __forceinline__ int fresh_lane() { int l; asm volatile("v_mbcnt_lo_u32_b32 %0, -1, 0\n\tv_mbcnt_hi_u32_b32 %0, -1, %0" : "=v"(l)); return l; }
__device__ __forceinline__ int fresh_tid(int wv) { return wv * 64 + fresh_lane(); }
namespace pg8 {
constexpr int BM = 256, BK = 64, HALF = 128, HTB = HALF * BK * 2, STAGE_BYTES = 8 * HTB, NXCD = 8, WGM = 8;
__host__ __device__ __forceinline__ int lds_byte(int r, int c) { const int st = (r >> 4) * 2 + (c >> 5), rr = r & 15, cc = c & 31, ob = rr * 64 + cc * 2; return st * 1024 + (ob ^ (((ob >> 9) & 1) << 5)); }
__host__ __device__ __forceinline__ void stage_rc(int b, int& R, int& C) { const int st = b / 1024, sb = b % 1024, swz = sb ^ (((sb >> 9) & 1) << 5); R = (st >> 1) * 16 + swz / 64; C = (st & 1) * 32 + (swz % 64) / 2; }
__host__ __device__ __forceinline__ int perm32(int rho) { const int n = rho >> 4, i = rho & 15; return 8 * (i >> 2) + 4 * n + (i & 3); }

struct Unit { int pm, pn; };
struct Gemm { const GAS bf16* A; const GAS bf16* Bt; int M, N, K; };
struct StaticOrder {
    int nM, nN, nwg, G, c;
    __device__ void init(int M, int N, int G_, int c_) { nM = M / BM; nN = N / BM; nwg = nM * nN; G = G_; c = c_; }
    __device__ bool next(int i, Unit& u) const {
        const long L = (long)i * G + c; if (L >= nwg) return false;
        int wgid = (int)L; { const int q = nwg / NXCD, r = nwg % NXCD, xcd = wgid % NXCD, off = wgid / NXCD; wgid = (xcd < r ? xcd * (q + 1) : r * (q + 1) + (xcd - r) * q) + off; }
        const int nig = WGM * nN, gid = wgid / nig, fm = gid * WGM, gsz = (nM - fm) < WGM ? (nM - fm) : WGM;
        u.pm = fm + ((wgid % nig) % gsz); u.pn = (wgid % nig) / gsz; return true;
    }
    __device__ __forceinline__ void a_ready(const Unit&, int) const {}
    __device__ __forceinline__ void done(int, int) const {}
};

struct RetOrder {
    StaticOrder so;
    __device__ void init(int M, int N, int G_, int c_) { so.init(M, N, G_, c_); }
    __device__ bool next(int i, Unit& u) const { if (!so.next(i, u)) return false; const int sl = u.pn; u.pn = (sl % 3 == 0) ? sl / 3 : 16 + (sl - sl / 3 - 1); return true; }
    __device__ __forceinline__ void a_ready(const Unit&, int) const {}
    __device__ __forceinline__ void done(int, int) const {}
};
struct TailOrder {
    StaticOrder so; int c, G; gu32* cnt;
    __device__ void init(int N, int G_, int c_, gu32* cnt_) { so.init(MP, N, G_, c_); c = c_; G = G_; cnt = cnt_; }
    __device__ bool next(int i, Unit& u) const {
        if (i == 0) return so.next(0, u);
        if (i == 1 && c >= G - 16) { u.pm = 32 + ((c - (G - 16)) >> 3); u.pn = (c - (G - 16)) & 7; return true; }
        return false;
    }
    __device__ __forceinline__ void a_ready(const Unit&, int) const {}
    __device__ __forceinline__ void done(int i, int) const {
        if (c < G - 16) return;
        asm volatile("s_waitcnt vmcnt(0)" ::: "memory");
        __builtin_amdgcn_fence(__ATOMIC_RELEASE, "agent");
        asm volatile("s_waitcnt vmcnt(0)" ::: "memory");
        if (fresh_lane() == 0) (void)__hip_atomic_fetch_add(cnt + (i ? 64 : 0), 1u, __ATOMIC_RELAXED, __HIP_MEMORY_SCOPE_AGENT);
    }
};
__device__ __forceinline__ void wait_count(gu32* p, unsigned want) {
    unsigned spins = 0;
    while ((unsigned)__builtin_amdgcn_readfirstlane(__hip_atomic_load(p, __ATOMIC_RELAXED, __HIP_MEMORY_SCOPE_AGENT)) < want) { __builtin_amdgcn_s_sleep(4); if (++spins > (1u << 24)) break; }
    __builtin_amdgcn_fence(__ATOMIC_ACQUIRE, "agent");
}
struct GuardOrder {
    StaticOrder so; gu32* cnt;
    __device__ void init(int M, int N, int G_, int c_, gu32* cnt_) { so.init(M, N, G_, c_); cnt = cnt_; }
    __device__ bool next(int i, Unit& u) const {
        const int c = so.c, G = so.G;
        if (c >= G - 16 && i >= 4) return false;
        if (c >= G - 40 && c < G - 24 && i == 5) { StaticOrder t = so; t.c = c + 24; return t.next(4, u); }
        return so.next(i, u);
    }
    __device__ __forceinline__ void a_ready(const Unit& u, int) const { if (u.pm >= 32) wait_count(cnt + 64, 128u); }
    __device__ __forceinline__ void done(int, int) const {}
};
template <class Epi, class Sched>
__device__ __forceinline__ void gemm_phase(LAS unsigned char* lds, const Gemm g, const Sched& S, const Epi& E, const int wv) {
    const int tid = fresh_tid(wv), wid = wv, lane = tid & 63, wr = wid >> 2, wc = wid & 3, fr = lane & 15, fq = lane >> 4;
    const int K = g.K, nt = K / BK;
    constexpr bool XR = Epi::XROWS;
    unsigned voffA[2], voffB[2];
#pragma unroll
    for (int i = 0; i < 2; ++i) { int R, C; stage_rc(tid * 16 + i * 8192, R, C); const int Rb = Epi::PERM ? ((R & ~31) + perm32(R & 31)) : R;
        voffA[i] = (unsigned)(R * K + C) * 2u; voffB[i] = (unsigned)(Rb * (K + WPAD) + C) * 2u; }
    const size_t kstep = (size_t)(BK * 2);
    const size_t hstepA = (size_t)HALF * K * 2, hstepB = hstepA + (size_t)HALF * WPAD * 2;
    const size_t tstepA = XR ? (size_t)272 * K * 2 : 2 * hstepA, tstepB = 2 * hstepB;
    const unsigned ldsw = (unsigned)wid * 1024u;
    const int aoff = lds_byte(wr * 64 + fr, fq * 8), boff = lds_byte(wc * 32 + fr, fq * 8);
    unsigned voffX = 0; const bool xl = lane < 16; const int xoff = lds_byte(fr, fq * 8);
    if constexpr (XR) { int R, C; stage_rc(wid * 256 + (lane & 15) * 16, R, C); voffX = (unsigned)((256 + R) * K + C) * 2u; }
#define PG8_STAGEX(b, gbase) do { if constexpr (XR) { if (xl) __builtin_amdgcn_global_load_lds((const GAS unsigned*)((const GAS char*)(gbase) + voffX), (LAS unsigned*)(lds + STAGE_BYTES + (b) * 2048 + wid * 256), 16, 0, 0); } } while (0)
#define PG8_LDX(b) do { if constexpr (XR) { _Pragma("unroll") for (int k = 0; k < 2; ++k) Ax[k] = *(const LAS bf16x8*)(lds + STAGE_BYTES + (b) * 2048 + xoff + k * 1024); } } while (0)
#define PG8_MMAX1(Bt) do { _Pragma("unroll") for (int n = 0; n < 2; ++n) _Pragma("unroll") for (int k = 0; k < 2; ++k) accx[n] = __builtin_amdgcn_mfma_f32_16x16x32_bf16(Bt[n][k], Ax[k], accx[n], 0, 0, 0); } while (0)
#define PG8_MMAX() do { if constexpr (XR) { if (wr) PG8_MMAX1(B1); else PG8_MMAX1(B0); } } while (0)
#define PG8_WAIT_VK() do { if constexpr (XR) asm volatile("s_waitcnt vmcnt(9)" ::: "memory"); else asm volatile("s_waitcnt vmcnt(8)" ::: "memory"); } while (0)
#define PG8_SA(b, h) (((b) * 2 + (h)) * HTB)
#define PG8_SB(b, h) ((4 + (b) * 2 + (h)) * HTB)
#define PG8_STAGE(bufoff, gbase, voff) do { _Pragma("unroll") for (int _i = 0; _i < 2; ++_i) \
        __builtin_amdgcn_global_load_lds((const GAS unsigned*)((const GAS char*)(gbase) + (voff)[_i]), (LAS unsigned*)(lds + (bufoff) + ldsw + _i * 8192), 16, 0, 0); } while (0)
#define PG8_LDA(dst, b, h) do { _Pragma("unroll") for (int m = 0; m < 4; ++m) _Pragma("unroll") for (int k = 0; k < 2; ++k) dst[m][k] = *(const LAS bf16x8*)(lds + PG8_SA(b, h) + aoff + m * 2048 + k * 1024); } while (0)
#define PG8_LDB(dst, b, h) do { _Pragma("unroll") for (int n = 0; n < 2; ++n) _Pragma("unroll") for (int k = 0; k < 2; ++k) dst[n][k] = *(const LAS bf16x8*)(lds + PG8_SB(b, h) + boff + n * 2048 + k * 1024); } while (0)
#define PG8_MMA(ai, bj, At, Bt) do { __builtin_amdgcn_s_setprio(1); _Pragma("unroll") for (int m = 0; m < 4; ++m) _Pragma("unroll") for (int n = 0; n < 2; ++n) _Pragma("unroll") for (int k = 0; k < 2; ++k) \
        acc[ai][bj][m][n] = __builtin_amdgcn_mfma_f32_16x16x32_bf16(Bt[n][k], At[m][k], acc[ai][bj][m][n], 0, 0, 0); __builtin_amdgcn_s_setprio(0); } while (0)
#define PG8_WAIT_V(n) asm volatile("s_waitcnt vmcnt(" #n ")" ::: "memory")
#define PG8_WAIT_L(n) asm volatile("s_waitcnt lgkmcnt(" #n ")" ::: "memory")
#define PG8_BAR __builtin_amdgcn_s_barrier()
#define PG8_SCHED __builtin_amdgcn_sched_barrier(0)
    Unit cur, nxt; int ui = 0;
    if (!S.next(0, cur)) return;
    f32x4 acc[2][2][4][2];
#pragma unroll
    for (int a = 0; a < 2; ++a)
#pragma unroll
        for (int b = 0; b < 2; ++b)
#pragma unroll
            for (int m = 0; m < 4; ++m)
#pragma unroll
                for (int n = 0; n < 2; ++n) acc[a][b][m][n] = (f32x4){0.f, 0.f, 0.f, 0.f};
    bf16x8 At[4][2], B0[2][2], B1[2][2], Ax[2];
    f32x4 accx[2] = {(f32x4){0.f, 0.f, 0.f, 0.f}, (f32x4){0.f, 0.f, 0.f, 0.f}};
    const GAS char* cA = (const GAS char*)g.A + (size_t)cur.pm * tstepA; const GAS char* cB = (const GAS char*)g.Bt + (size_t)cur.pn * tstepB;
    S.a_ready(cur, wv);
    PG8_STAGE(PG8_SB(0, 0), cB, voffB); PG8_STAGE(PG8_SB(0, 1), cB + hstepB, voffB); PG8_STAGE(PG8_SA(0, 0), cA, voffA); PG8_STAGE(PG8_SA(0, 1), cA + hstepA, voffA); PG8_STAGEX(0, cA);
    if (wr == 1) PG8_BAR;
    if constexpr (XR) PG8_WAIT_V(3); else PG8_WAIT_V(2);
    PG8_BAR;
    PG8_STAGE(PG8_SB(1, 0), cB + kstep, voffB); PG8_STAGE(PG8_SA(1, 0), cA + kstep, voffA); PG8_STAGE(PG8_SB(1, 1), cB + hstepB + kstep, voffB);
    PG8_WAIT_V(6); PG8_BAR;
    for (;;) {
        const bool has_next = S.next(ui + 1, nxt);
        const GAS char* nA = has_next ? (const GAS char*)g.A + (size_t)nxt.pm * tstepA : cA; const GAS char* nB = has_next ? (const GAS char*)g.Bt + (size_t)nxt.pn * tstepB : cB;
        for (int tseg = 0; tseg < nt; tseg += (Epi::HORNER ? 8 : nt)) {
        if constexpr (Epi::HORNER) { if (tseg != 0) { E.rescale(acc, cur, tseg >> 3, wv); if constexpr (XR) E.rescale_x(accx, cur, tseg >> 3, wv); } }
        const int tend = Epi::HORNER ? tseg + 8 : nt;
        for (int t = tseg; t < tend; t += 2) {
            const bool last = (t == nt - 2);
            const GAS char* a1 = cA + (size_t)(t + 1) * kstep;
            const GAS char* a2 = last ? nA : cA + (size_t)(t + 2) * kstep; const GAS char* b2 = last ? nB : cB + (size_t)(t + 2) * kstep;
            const GAS char* a3 = a2 + kstep; const GAS char* b3 = b2 + kstep;
            if (last && has_next) S.a_ready(nxt, wv);
            PG8_LDB(B0, 0, 0); PG8_LDB(B1, 0, 1); PG8_SCHED; PG8_LDA(At, 0, 0); PG8_STAGE(PG8_SA(1, 1), a1 + hstepA, voffA); PG8_STAGEX(1, a1);
            PG8_WAIT_VK(); PG8_WAIT_L(0); PG8_BAR; PG8_MMA(0, 0, At, B0); PG8_MMA(0, 1, At, B1); PG8_BAR; PG8_SCHED;
            PG8_LDA(At, 0, 1); PG8_LDX(0); PG8_STAGE(PG8_SB(0, 0), b2, voffB); PG8_STAGE(PG8_SB(0, 1), b2 + hstepB, voffB); PG8_STAGE(PG8_SA(0, 0), a2, voffA);
            PG8_WAIT_VK(); PG8_WAIT_L(0); PG8_BAR; PG8_MMA(1, 0, At, B0); PG8_MMA(1, 1, At, B1); PG8_MMAX(); PG8_BAR; PG8_SCHED;
            PG8_LDB(B0, 1, 0); PG8_LDB(B1, 1, 1); PG8_SCHED; PG8_LDA(At, 1, 0); PG8_STAGE(PG8_SA(0, 1), a2 + hstepA, voffA); PG8_STAGEX(0, a2);
            PG8_WAIT_VK(); PG8_WAIT_L(0); PG8_BAR; PG8_MMA(0, 0, At, B0); PG8_MMA(0, 1, At, B1); PG8_BAR; PG8_SCHED;
            PG8_LDA(At, 1, 1); PG8_LDX(1); PG8_STAGE(PG8_SB(1, 0), b3, voffB); PG8_STAGE(PG8_SB(1, 1), b3 + hstepB, voffB); PG8_STAGE(PG8_SA(1, 0), a3, voffA);
            PG8_WAIT_VK(); PG8_WAIT_L(0); PG8_BAR; PG8_MMA(1, 0, At, B0); PG8_MMA(1, 1, At, B1); PG8_MMAX(); PG8_BAR; PG8_SCHED;
        }
        }
        if (wr == 0) PG8_BAR;
        if constexpr (Epi::FINAL) E.final(acc, accx, cur, wv);
        else { E(acc, cur, wv); if constexpr (XR) E.extra(accx, cur, wv); }
        S.done(ui, wv);
        if (!has_next) break;
#pragma unroll
        for (int a = 0; a < 2; ++a)
#pragma unroll
            for (int b = 0; b < 2; ++b)
#pragma unroll
                for (int m = 0; m < 4; ++m)
#pragma unroll
                    for (int n = 0; n < 2; ++n) acc[a][b][m][n] = (f32x4){0.f, 0.f, 0.f, 0.f};
        accx[0] = (f32x4){0.f, 0.f, 0.f, 0.f}; accx[1] = accx[0];
        cur = nxt; cA = nA; cB = nB; ++ui;
        if (wr == 1) PG8_BAR;
    }
    PG8_WAIT_V(0);
    PG8_BAR;
#undef PG8_SA
#undef PG8_SB
#undef PG8_STAGE
#undef PG8_STAGEX
#undef PG8_LDX
#undef PG8_MMAX1
#undef PG8_MMAX
#undef PG8_WAIT_VK
#undef PG8_LDA
#undef PG8_LDB
#undef PG8_MMA
#undef PG8_WAIT_V
#undef PG8_WAIT_L
#undef PG8_BAR
#undef PG8_SCHED
}
}

struct LaneIdx { int wr, wc, fr, fq; };
__device__ __forceinline__ LaneIdx lane_idx(int wv) { const int t = fresh_lane(); LaneIdx L; L.wr = wv >> 2; L.wc = wv & 3; L.fr = t & 15; L.fq = (t >> 4) & 3; return L; }
__device__ __forceinline__ u32x4 pack8(const f32x4 a, const f32x4 b) { u32x4 w; w.x = cvt_pk_bf16(a[0], a[1]); w.y = cvt_pk_bf16(a[2], a[3]); w.z = cvt_pk_bf16(b[0], b[1]); w.w = cvt_pk_bf16(b[2], b[3]); return w; }
__device__ __forceinline__ f32x4 silu4(f32x4 v) { f32x4 o; o[0] = silu_f(v[0]); o[1] = silu_f(v[1]); o[2] = silu_f(v[2]); o[3] = silu_f(v[3]); return o; }

struct EpiRetIn {
    static constexpr bool PERM = true, HORNER = false, XROWS = true, FINAL = true;
    static constexpr int BMR = 272;
    LAS float* xch;
    GAS bf16* Q; GAS bf16* Kb; GAS bf16* V; GAS bf16* G; const GAS float* ssq; const GAS double* invrev;
    __device__ __forceinline__ void rescale(f32x4 (&)[2][2][4][2], const pg8::Unit&, int, int) const {}
    __device__ __forceinline__ void rescale_x(f32x4 (&)[2], const pg8::Unit&, int, int) const {}
    __device__ __forceinline__ void final(f32x4 (&acc)[2][2][4][2], f32x4 (&accx)[2], const pg8::Unit& u, const int wv) const {
        const LaneIdx L_ = lane_idx(wv); const int wr = L_.wr, wc = L_.wc, fr = L_.fr, fq = L_.fq;
        const int row0 = u.pm * BMR + wr * 64 + fr, rowx = u.pm * BMR + 256 + fr, pn = u.pn, d0 = wc * 32 + 8 * fq, lane = fq * 16 + fr;
        float rsv[2][4];
#pragma unroll
        for (int ai = 0; ai < 2; ++ai)
#pragma unroll
            for (int m = 0; m < 4; ++m) rsv[ai][m] = ssq[row0 + ai * 128 + m * 16];
        const float rsx0 = ssq[rowx];
        if (pn < 16) {
            float fq8[8];
#pragma unroll
            for (int j = 0; j < 8; ++j) fq8[j] = (float)invrev[d0 + j];
            LAS f32x4* mine = (LAS f32x4*)(xch + (wv * 64 + lane) * 8); mine[0] = accx[0]; mine[1] = accx[1];
            asm volatile("s_waitcnt lgkmcnt(0)" ::: "memory"); __builtin_amdgcn_s_barrier();
            const LAS f32x4* oth = (const LAS f32x4*)(xch + ((wv ^ 4) * 64 + lane) * 8); const f32x4 pa = oth[0], pb = oth[1];
            const bool isk = pn >= 8; const int h = pn & 7; GAS bf16* dst = (isk ? Kb : Q) + h * 256 + d0; const float sc = isk ? 0.0625f : 1.0f;
#pragma unroll
            for (int ai = 0; ai < 2; ++ai)
#pragma unroll
                for (int m = 0; m < 4; ++m) {
                    const int row = row0 + ai * 128 + m * 16;
                    const float rs = __builtin_amdgcn_rsqf(rsv[ai][m] * (1.0f / DM) + EPS) * sc;
                    const float pos = (float)(row < MP ? (row & 2047) : 4096 + ((row - MP) & 63));
                    f32x4 c0, c1, s0, s1;
#pragma unroll
                    for (int j = 0; j < 4; ++j) { const float r0 = __builtin_amdgcn_fractf(pos * fq8[j]), r1 = __builtin_amdgcn_fractf(pos * fq8[4 + j]);
                        c0[j] = __builtin_amdgcn_cosf(r0); s0[j] = __builtin_amdgcn_sinf(r0); c1[j] = __builtin_amdgcn_cosf(r1); s1[j] = __builtin_amdgcn_sinf(r1); }
                    const f32x4 x1a = acc[ai][0][m][0], x1b = acc[ai][0][m][1], x2a = acc[ai][1][m][0], x2b = acc[ai][1][m][1];
                    const f32x4 o1a = (x1a * c0 - x2a * s0) * rs, o1b = (x1b * c1 - x2b * s1) * rs;
                    const f32x4 o2a = (x2a * c0 + x1a * s0) * rs, o2b = (x2b * c1 + x1b * s1) * rs;
                    *(GAS u32x4*)(dst + (size_t)row * DM) = pack8(o1a, o1b);
                    *(GAS u32x4*)(dst + (size_t)row * DM + 128) = pack8(o2a, o2b);
                }
            { const float rs = __builtin_amdgcn_rsqf(rsx0 * (1.0f / DM) + EPS) * sc;
              const float pos = (float)(rowx < MP ? (rowx & 2047) : 4096 + ((rowx - MP) & 63));
              f32x4 c0, c1, s0, s1;
#pragma unroll
              for (int j = 0; j < 4; ++j) { const float r0 = __builtin_amdgcn_fractf(pos * fq8[j]), r1 = __builtin_amdgcn_fractf(pos * fq8[4 + j]);
                  c0[j] = __builtin_amdgcn_cosf(r0); s0[j] = __builtin_amdgcn_sinf(r0); c1[j] = __builtin_amdgcn_cosf(r1); s1[j] = __builtin_amdgcn_sinf(r1); }
              if (wr) { s0 = -s0; s1 = -s1; }
              const f32x4 oa = (accx[0] * c0 - pa * s0) * rs, ob = (accx[1] * c1 - pb * s1) * rs;
              *(GAS u32x4*)(dst + wr * 128 + (size_t)rowx * DM) = pack8(oa, ob); }
        } else {
            const bool isg = pn >= 32; GAS bf16* dst = (isg ? G : V) + ((pn - 16) & 15) * 256 + d0;
#pragma unroll
            for (int ai = 0; ai < 2; ++ai)
#pragma unroll
                for (int m = 0; m < 4; ++m) {
                    const int row = row0 + ai * 128 + m * 16;
                    const float rs = __builtin_amdgcn_rsqf(rsv[ai][m] * (1.0f / DM) + EPS);
#pragma unroll
                    for (int bj = 0; bj < 2; ++bj) {
                        f32x4 v0 = acc[ai][bj][m][0] * rs, v1 = acc[ai][bj][m][1] * rs;
                        if (isg) { v0 = silu4(v0); v1 = silu4(v1); }
                        *(GAS u32x4*)(dst + (size_t)row * VDIM + bj * 128) = pack8(v0, v1);
                    }
                }
            { const float rs = __builtin_amdgcn_rsqf(rsx0 * (1.0f / DM) + EPS);
              f32x4 v0 = accx[0] * rs, v1 = accx[1] * rs;
              if (isg) { v0 = silu4(v0); v1 = silu4(v1); }
              *(GAS u32x4*)(dst + wr * 128 + (size_t)rowx * VDIM) = pack8(v0, v1); }
        }
    }
};

struct EpiFfnGU {
    static constexpr bool PERM = true, HORNER = false, XROWS = false, FINAL = false;
    GAS bf16* H; const GAS float* ssq;
    __device__ __forceinline__ void rescale(f32x4 (&)[2][2][4][2], const pg8::Unit&, int, int) const {}
    __device__ __forceinline__ void operator()(const f32x4 (&acc)[2][2][4][2], const pg8::Unit& u, const int wv) const {
        const LaneIdx L_ = lane_idx(wv); const int wr = L_.wr, wc = L_.wc, fr = L_.fr, fq = L_.fq; (void)wr; (void)wc; (void)fr; (void)fq;
        const int row0 = u.pm * 256 + wr * 64 + fr; GAS bf16* dst = H + u.pn * 128 + wc * 32 + 8 * fq;
        float rsv[2][4];
#pragma unroll
        for (int ai = 0; ai < 2; ++ai)
#pragma unroll
            for (int m = 0; m < 4; ++m) rsv[ai][m] = ssq[row0 + ai * 128 + m * 16];
#pragma unroll
        for (int ai = 0; ai < 2; ++ai)
#pragma unroll
            for (int m = 0; m < 4; ++m) {
                const int row = row0 + ai * 128 + m * 16;
                const float rs = __builtin_amdgcn_rsqf(rsv[ai][m] * (1.0f / DM) + EPS);
                const f32x4 g0 = silu4(acc[ai][0][m][0] * rs), g1 = silu4(acc[ai][0][m][1] * rs);
                const f32x4 u0 = acc[ai][1][m][0] * rs, u1 = acc[ai][1][m][1] * rs;
                *(GAS u32x4*)(dst + (size_t)row * FF) = pack8(g0 * u0, g1 * u1);
            }
    }
};

template <bool HORN, bool XRW = false> struct EpiResid {
    static constexpr bool PERM = true, HORNER = HORN, XROWS = XRW, FINAL = XRW;
    static constexpr int BMR = XRW ? 272 : 256;
    GAS bf16* xb; GAS float* ssq_out; const GAS float* ssn; const GAS float* xin0; const GAS float* xin1;
    __device__ __forceinline__ void rescale(f32x4 (&acc)[2][2][4][2], const pg8::Unit& u, int seg, const int wv) const {
        const LaneIdx L_ = lane_idx(wv); const int wr = L_.wr, fr = L_.fr;
        const unsigned voff = (unsigned)(wr * 64 + fr) * 32u;
        const GAS char* base = (const GAS char*)(ssn + (size_t)u.pm * BMR * 8 + seg - 1);
        float a0[2][4], b0[2][4];
#pragma unroll
        for (int ai = 0; ai < 2; ++ai)
#pragma unroll
            for (int m = 0; m < 4; ++m) { a0[ai][m] = *(const GAS float*)(base + (ai * 128 + m * 16) * 32 + voff); b0[ai][m] = *(const GAS float*)(base + (ai * 128 + m * 16) * 32 + 4 + voff); }
#pragma unroll
        for (int ai = 0; ai < 2; ++ai)
#pragma unroll
            for (int m = 0; m < 4; ++m) {
                const float a = a0[ai][m] * (1.0f / 512) + EPS, b = b0[ai][m] * (1.0f / 512) + EPS;
                const float r = __builtin_amdgcn_sqrtf(b * __builtin_amdgcn_rcpf(a));
#pragma unroll
                for (int bj = 0; bj < 2; ++bj)
#pragma unroll
                    for (int n = 0; n < 2; ++n) acc[ai][bj][m][n] = acc[ai][bj][m][n] * r;
            }
    }
    __device__ __forceinline__ void operator()(const f32x4 (&acc)[2][2][4][2], const pg8::Unit& u, const int wv) const {
        const LaneIdx L_ = lane_idx(wv); const int wr = L_.wr, wc = L_.wc, fr = L_.fr, fq = L_.fq; (void)wr; (void)wc; (void)fr; (void)fq;
        const int row0 = u.pm * BMR + wr * 64 + fr, col0 = u.pn * 256 + wc * 32 + 8 * fq;
#pragma unroll
        for (int ai = 0; ai < 2; ++ai)
#pragma unroll
            for (int m = 0; m < 4; ++m) {
                const int row = row0 + ai * 128 + m * 16;
                float sc = 1.0f; if (HORN) sc = __builtin_amdgcn_rsqf(ssn[row * 8 + 7] * (1.0f / 512) + EPS);
                float sq = 0.f;
#pragma unroll
                for (int bj = 0; bj < 2; ++bj) {
                    const size_t o = (size_t)row * DM + col0 + bj * 128;
                    f32x4 x0, x1;
                    if (xin0) { const GAS float* xs_ = row < MP ? xin0 + o : xin1 + (o - (size_t)MP * DM); x0 = *(const GAS f32x4*)xs_; x1 = *(const GAS f32x4*)(xs_ + 4); }
                    else { const u32x4 w = *(const GAS u32x4*)(xb + o); x0 = (f32x4){bf_lo(w.x), bf_hi(w.x), bf_lo(w.y), bf_hi(w.y)}; x1 = (f32x4){bf_lo(w.z), bf_hi(w.z), bf_lo(w.w), bf_hi(w.w)}; }
                    x0 = x0 + acc[ai][bj][m][0] * sc; x1 = x1 + acc[ai][bj][m][1] * sc;
                    *(GAS u32x4*)(xb + o) = pack8(x0, x1);
                    sq += ((x0[0] * x0[0] + x0[1] * x0[1]) + (x0[2] * x0[2] + x0[3] * x0[3])) + ((x1[0] * x1[0] + x1[1] * x1[1]) + (x1[2] * x1[2] + x1[3] * x1[3]));
                }
                sq = rows_sum4(sq);
                if (fq == 0) (void)__hip_atomic_fetch_add(ssq_out + row, sq, __ATOMIC_RELAXED, __HIP_MEMORY_SCOPE_AGENT);
                asm volatile("" ::: "memory");
            }
    }
    __device__ __forceinline__ void final(f32x4 (&acc)[2][2][4][2], f32x4 (&accx)[2], const pg8::Unit& u, const int wv) const {
        const LaneIdx L_ = lane_idx(wv); const int wr = L_.wr, wc = L_.wc, fr = L_.fr, fq = L_.fq;
        const int rowx = u.pm * BMR + 256 + fr;
        const size_t ox = (size_t)rowx * DM + u.pn * 256 + wr * 128 + wc * 32 + 8 * fq;
        float scx = 1.0f; if (HORN) scx = ssn[rowx * 8 + 7];
        f32x4 x0, x1;
        if (xin0) { const GAS float* xs_ = rowx < MP ? xin0 + ox : xin1 + (ox - (size_t)MP * DM); x0 = *(const GAS f32x4*)xs_; x1 = *(const GAS f32x4*)(xs_ + 4); }
        else { const u32x4 w = *(const GAS u32x4*)(xb + ox); x0 = (f32x4){bf_lo(w.x), bf_hi(w.x), bf_lo(w.y), bf_hi(w.y)}; x1 = (f32x4){bf_lo(w.z), bf_hi(w.z), bf_lo(w.w), bf_hi(w.w)}; }
        (*this)(acc, u, wv);
        if (HORN) scx = __builtin_amdgcn_rsqf(scx * (1.0f / 512) + EPS);
        x0 = x0 + accx[0] * scx; x1 = x1 + accx[1] * scx;
        *(GAS u32x4*)(xb + ox) = pack8(x0, x1);
        float sq = ((x0[0] * x0[0] + x0[1] * x0[1]) + (x0[2] * x0[2] + x0[3] * x0[3])) + ((x1[0] * x1[0] + x1[1] * x1[1]) + (x1[2] * x1[2] + x1[3] * x1[3]));
        sq = rows_sum4(sq);
        if (fq == 0) (void)__hip_atomic_fetch_add(ssq_out + rowx, sq, __ATOMIC_RELAXED, __HIP_MEMORY_SCOPE_AGENT);
    }
    __device__ __forceinline__ void rescale_x(f32x4 (&accx)[2], const pg8::Unit& u, int seg, const int wv) const {
        const LaneIdx L_ = lane_idx(wv);
        const GAS float* p = ssn + ((size_t)u.pm * BMR + 256 + L_.fr) * 8 + seg - 1;
        const float a = p[0] * (1.0f / 512) + EPS, b = p[1] * (1.0f / 512) + EPS;
        const float r = __builtin_amdgcn_sqrtf(b * __builtin_amdgcn_rcpf(a));
        accx[0] = accx[0] * r; accx[1] = accx[1] * r;
    }
    __device__ __forceinline__ void extra(const f32x4 (&accx)[2], const pg8::Unit& u, const int wv) const {
        const LaneIdx L_ = lane_idx(wv); const int wr = L_.wr, wc = L_.wc, fr = L_.fr, fq = L_.fq;
        const int row = u.pm * BMR + 256 + fr;
        float sc = 1.0f; if (HORN) sc = __builtin_amdgcn_rsqf(ssn[row * 8 + 7] * (1.0f / 512) + EPS);
        const size_t o = (size_t)row * DM + u.pn * 256 + wr * 128 + wc * 32 + 8 * fq;
        f32x4 x0, x1;
        if (xin0) { const GAS float* xs_ = row < MP ? xin0 + o : xin1 + (o - (size_t)MP * DM); x0 = *(const GAS f32x4*)xs_; x1 = *(const GAS f32x4*)(xs_ + 4); }
        else { const u32x4 w = *(const GAS u32x4*)(xb + o); x0 = (f32x4){bf_lo(w.x), bf_hi(w.x), bf_lo(w.y), bf_hi(w.y)}; x1 = (f32x4){bf_lo(w.z), bf_hi(w.z), bf_lo(w.w), bf_hi(w.w)}; }
        x0 = x0 + accx[0] * sc; x1 = x1 + accx[1] * sc;
        *(GAS u32x4*)(xb + o) = pack8(x0, x1);
        float sq = ((x0[0] * x0[0] + x0[1] * x0[1]) + (x0[2] * x0[2] + x0[3] * x0[3])) + ((x1[0] * x1[0] + x1[1] * x1[1]) + (x1[2] * x1[2] + x1[3] * x1[3]));
        sq = rows_sum4(sq);
        if (fq == 0) (void)__hip_atomic_fetch_add(ssq_out + row, sq, __ATOMIC_RELAXED, __HIP_MEMORY_SCOPE_AGENT);
    }
};

struct EpiFinal {
    static constexpr bool PERM = true, HORNER = false, XROWS = true, FINAL = true;
    static constexpr int BMR = 272;
    const GAS bf16* xb; GAS float* ssq; const GAS float* lnw; GAS float* y; gu32* cnt;
    __device__ __forceinline__ void rescale(f32x4 (&)[2][2][4][2], const pg8::Unit&, int, int) const {}
    __device__ __forceinline__ void rescale_x(f32x4 (&)[2], const pg8::Unit&, int, int) const {}
    __device__ __forceinline__ void final(f32x4 (&acc)[2][2][4][2], f32x4 (&accx)[2], const pg8::Unit& u, const int wv) const {
        const LaneIdx L_ = lane_idx(wv); const int wr = L_.wr, wc = L_.wc, fr = L_.fr, fq = L_.fq;
        const int row0 = u.pm * BMR + wr * 64 + fr, col0 = u.pn * 256 + wc * 32 + 8 * fq;
        const int rowx = u.pm * BMR + 256 + fr, colx = u.pn * 256 + wr * 128 + wc * 32 + 8 * fq;
#pragma unroll
        for (int ai = 0; ai < 2; ++ai)
#pragma unroll
            for (int m = 0; m < 4; ++m) {
                const int row = row0 + ai * 128 + m * 16;
                float sq = 0.f;
#pragma unroll
                for (int bj = 0; bj < 2; ++bj) {
                    const u32x4 w = *(const GAS u32x4*)(xb + (size_t)row * DM + col0 + bj * 128);
                    const f32x4 x0 = (f32x4){bf_lo(w.x), bf_hi(w.x), bf_lo(w.y), bf_hi(w.y)} + acc[ai][bj][m][0], x1 = (f32x4){bf_lo(w.z), bf_hi(w.z), bf_lo(w.w), bf_hi(w.w)} + acc[ai][bj][m][1];
                    acc[ai][bj][m][0] = x0; acc[ai][bj][m][1] = x1;
                    sq += ((x0[0] * x0[0] + x0[1] * x0[1]) + (x0[2] * x0[2] + x0[3] * x0[3])) + ((x1[0] * x1[0] + x1[1] * x1[1]) + (x1[2] * x1[2] + x1[3] * x1[3]));
                }
                sq = rows_sum4(sq);
                if (fq == 0) (void)__hip_atomic_fetch_add(ssq + row, sq, __ATOMIC_RELAXED, __HIP_MEMORY_SCOPE_AGENT);
                asm volatile("" ::: "memory");
            }
        { const u32x4 w = *(const GAS u32x4*)(xb + (size_t)rowx * DM + colx);
          const f32x4 x0 = (f32x4){bf_lo(w.x), bf_hi(w.x), bf_lo(w.y), bf_hi(w.y)} + accx[0], x1 = (f32x4){bf_lo(w.z), bf_hi(w.z), bf_lo(w.w), bf_hi(w.w)} + accx[1];
          accx[0] = x0; accx[1] = x1;
          float sq = ((x0[0] * x0[0] + x0[1] * x0[1]) + (x0[2] * x0[2] + x0[3] * x0[3])) + ((x1[0] * x1[0] + x1[1] * x1[1]) + (x1[2] * x1[2] + x1[3] * x1[3]));
          sq = rows_sum4(sq);
          if (fq == 0) (void)__hip_atomic_fetch_add(ssq + rowx, sq, __ATOMIC_RELAXED, __HIP_MEMORY_SCOPE_AGENT); }
        asm volatile("s_waitcnt vmcnt(0)" ::: "memory");
        __builtin_amdgcn_s_barrier();
        if (fresh_tid(wv) == 0) {
            gu32* c = cnt + u.pm * 64;
            __builtin_amdgcn_fence(__ATOMIC_RELEASE, "agent");
            asm volatile("s_waitcnt vmcnt(0)" ::: "memory");
            (void)__hip_atomic_fetch_add(c, 1u, __ATOMIC_RELAXED, __HIP_MEMORY_SCOPE_AGENT);
            unsigned sp = 0;
            while (__hip_atomic_load(c, __ATOMIC_RELAXED, __HIP_MEMORY_SCOPE_AGENT) < 8u) { __builtin_amdgcn_s_sleep(2); if (++sp > (1u << 22)) break; }
            __builtin_amdgcn_fence(__ATOMIC_ACQUIRE, "agent");
            asm volatile("s_waitcnt vmcnt(0)" ::: "memory");
        }
        __builtin_amdgcn_s_barrier();
        f32x4 lw[2][2];
#pragma unroll
        for (int bj = 0; bj < 2; ++bj) { lw[bj][0] = *(const GAS f32x4*)(lnw + col0 + bj * 128); lw[bj][1] = *(const GAS f32x4*)(lnw + col0 + bj * 128 + 4); }
        float sv[2][4];
#pragma unroll
        for (int ai = 0; ai < 2; ++ai)
#pragma unroll
            for (int m = 0; m < 4; ++m) sv[ai][m] = __hip_atomic_load(ssq + row0 + ai * 128 + m * 16, __ATOMIC_RELAXED, __HIP_MEMORY_SCOPE_AGENT);
        const float svx = __hip_atomic_load(ssq + rowx, __ATOMIC_RELAXED, __HIP_MEMORY_SCOPE_AGENT);
        const f32x4 lwx0 = *(const GAS f32x4*)(lnw + colx), lwx1 = *(const GAS f32x4*)(lnw + colx + 4);
#pragma unroll
        for (int ai = 0; ai < 2; ++ai)
#pragma unroll
            for (int m = 0; m < 4; ++m) {
                const int row = row0 + ai * 128 + m * 16;
                const float rs = __builtin_amdgcn_rsqf(sv[ai][m] * (1.0f / DM) + EPS);
#pragma unroll
                for (int bj = 0; bj < 2; ++bj) {
                    GAS float* d = y + (size_t)row * DM + col0 + bj * 128;
                    *(GAS f32x4*)d = acc[ai][bj][m][0] * rs * lw[bj][0]; *(GAS f32x4*)(d + 4) = acc[ai][bj][m][1] * rs * lw[bj][1];
                }
            }
        { const float rs = __builtin_amdgcn_rsqf(svx * (1.0f / DM) + EPS);
          GAS float* d = y + (size_t)rowx * DM + colx;
          *(GAS f32x4*)d = accx[0] * rs * lwx0; *(GAS f32x4*)(d + 4) = accx[1] * rs * lwx1; }
    }
};

struct EpiSsdIn {
    static constexpr bool PERM = true, HORNER = false, XROWS = false, FINAL = false;
    GAS bf16* Z; GAS bf16* XBC; GAS float* DT; const GAS float* ssq; const GAS float* dt_bias; GAS float* convP; GAS float* convS;
    __device__ __forceinline__ void rescale(f32x4 (&)[2][2][4][2], const pg8::Unit&, int, int) const {}
    __device__ __forceinline__ void operator()(const f32x4 (&acc)[2][2][4][2], const pg8::Unit& u, const int wv) const {
        const LaneIdx L_ = lane_idx(wv); const int wr = L_.wr, wc = L_.wc, fr = L_.fr, fq = L_.fq; (void)wr; (void)wc; (void)fr; (void)fq;
        const int row0 = u.pm * 256 + wr * 64 + fr, pn = u.pn, c0 = wc * 32 + 8 * fq;
        float rsv[2][4];
#pragma unroll
        for (int ai = 0; ai < 2; ++ai)
#pragma unroll
            for (int m = 0; m < 4; ++m) rsv[ai][m] = ssq[row0 + ai * 128 + m * 16];
#pragma unroll
        for (int ai = 0; ai < 2; ++ai)
#pragma unroll
            for (int m = 0; m < 4; ++m) {
                const int row = row0 + ai * 128 + m * 16;
                const float rs = __builtin_amdgcn_rsqf(rsv[ai][m] * (1.0f / DM) + EPS);
                if (pn < 16) {
#pragma unroll
                    for (int bj = 0; bj < 2; ++bj) {
                        *(GAS u32x4*)(Z + (size_t)row * VDIM + pn * 256 + bj * 128 + c0) = pack8(silu4(acc[ai][bj][m][0] * rs), silu4(acc[ai][bj][m][1] * rs));
                    }
                } else if (pn < 40) {
                    int t3 = -1; GAS float* cdst = nullptr;
                    if (row < MP) { const int t = row & 2047; if (t >= 2045) { t3 = t - 2045; cdst = convP + (size_t)((row >> 11) * 3 + t3) * CONVD; } }
                    else { const int rr = row - MP, t = rr & 63; if (t >= 61) { t3 = t - 61; cdst = convS + (size_t)((rr >> 6) * 3 + t3) * CONVD; } }
#pragma unroll
                    for (int bj = 0; bj < 2; ++bj) {
                        const int col = (pn - 16) * 256 + bj * 128 + c0;
                        const f32x4 v0 = acc[ai][bj][m][0] * rs, v1 = acc[ai][bj][m][1] * rs;
                        *(GAS u32x4*)(XBC + (size_t)row * CONVD + col) = pack8(v0, v1);
                        if (t3 >= 0) { *(GAS f32x4*)(cdst + col) = v0; *(GAS f32x4*)(cdst + col + 4) = v1; }
                    }
                } else if (wc < 2) {
                    const f32x4 b0 = *(const GAS f32x4*)(dt_bias + c0), b1 = *(const GAS f32x4*)(dt_bias + c0 + 4);
                    f32x4 v0 = acc[ai][0][m][0] * rs + b0, v1 = acc[ai][0][m][1] * rs + b1;
#pragma unroll
                    for (int j = 0; j < 4; ++j) { v0[j] = softplus_f(v0[j]); v1[j] = softplus_f(v1[j]); }
                    *(GAS f32x4*)(DT + (size_t)row * 64 + c0) = v0; *(GAS f32x4*)(DT + (size_t)row * 64 + c0 + 4) = v1;
                }
            }
    }
};

template <int OFF0, int OFF1> __device__ __forceinline__ bf16x8 tr_frag_i(unsigned base) {
    const s16x4 lo = __builtin_amdgcn_ds_read_tr16_b64_v4i16((LAS s16x4*)(uintptr_t)(base + OFF0));
    const s16x4 hi = __builtin_amdgcn_ds_read_tr16_b64_v4i16((LAS s16x4*)(uintptr_t)(base + OFF1));
    return __builtin_shufflevector(lo, hi, 0, 1, 2, 3, 4, 5, 6, 7);
}
template <int OFF, int ROWSTEP> __device__ __forceinline__ void tr_frag4(unsigned base, bf16x8& f0, bf16x8& f1, bf16x8& f2, bf16x8& f3) {
    f0 = tr_frag_i<OFF, OFF + ROWSTEP>(base); f1 = tr_frag_i<OFF + 32, OFF + 32 + ROWSTEP>(base);
    f2 = tr_frag_i<OFF + 64, OFF + 64 + ROWSTEP>(base); f3 = tr_frag_i<OFF + 96, OFF + 96 + ROWSTEP>(base);
}
struct ScanItem {
    const GAS bf16* qg; const GAS bf16* kg; const GAS bf16* vg; int ldq, ldv;
    const GAS bf16* gg; GAS bf16* yg; int ldg;
    GAS float* ssqg; int ssq_col;
    int rowbase, nsteps;
    const GAS float* s_in; GAS float* s_out; int sd, se;
    float lg2;
    const GAS float* dtg; float Ah, Dh;
};
template <int MODE>
__device__ __forceinline__ void scan_chain(LAS unsigned char* lds, const ScanItem& it, const int wv) {
    constexpr int DK = MODE ? 128 : 256, RSQ = 2 * DK + 32, RSV = 144, NQC = DK / 64, DH = DK / 2, NDT = DH / 16, NK3 = DH / 32, NK1 = DK / 32, CPR = DK / 8;
    constexpr int RST = RSQ - 16;
    constexpr int O_QI = 0, O_KI = 64 * RSQ, O_ST = 2 * 64 * RSQ, O_VI = 3 * 64 * RSQ, O_VS = O_VI + 64 * RSV, O_PI = O_VS + 64 * RSV, O_XC = O_PI + 64 * RSV, O_SSQ = O_XC + 16384;
    static_assert(O_SSQ + 512 + 512 <= MISC_OFF, "scan LDS");
    const int tid = fresh_tid(wv), w = wv, lane = tid & 63, fr = lane & 15, g = lane >> 4, q4 = fr >> 2, p4 = fr & 3, wd = w >> 2, we = w & 3;
    const unsigned lbase = (unsigned)(uintptr_t)lds;
    LAS float* ssqL = (LAS float*)(lds + O_SSQ);
    LAS float* dcL = (LAS float*)(lds + O_SSQ + 512);
    f32x4 S[NDT];
    if (it.s_in) {
        const GAS float* sp = it.s_in + (size_t)(wd * DH + 4 * g) * it.sd + (size_t)(16 * we + fr) * it.se;
#pragma unroll
        for (int dt = 0; dt < NDT; ++dt)
#pragma unroll
            for (int r = 0; r < 4; ++r) S[dt][r] = sp[(size_t)(16 * dt + r) * it.sd];
    } else {
#pragma unroll
        for (int dt = 0; dt < NDT; ++dt) S[dt] = (f32x4){0.f, 0.f, 0.f, 0.f};
    }
    if (tid < 128) ssqL[tid] = 0.f;
    const unsigned voq = (unsigned)((tid / CPR) * it.ldq + (tid % CPR) * 8) * 2u;
    const unsigned vov = (unsigned)((tid >> 3) * it.ldv + (tid & 7) * 8) * 2u;
    const unsigned vog = (unsigned)((16 * 2 * wd + fr) * it.ldg + 16 * we + 4 * g) * 2u;
    const int d0p = ((tid % CPR) * 8) & 31;
    const unsigned lq = (unsigned)((tid / CPR) * RSQ + ((((tid % CPR) * 8) & ~31) + 8 * ((d0p & 15) >> 2) + 4 * (d0p >> 4)) * 2), lv = (unsigned)((tid >> 3) * RSV + (tid & 7) * 16);
    const unsigned kbase = lbase + O_KI + (8 * g + q4) * RSQ + (wd * DH + 8 * p4) * 2;
    const unsigned vsbase = lbase + O_VS + (8 * g + q4) * RSV + (16 * we + 4 * p4) * 2;
    const unsigned vibase = lbase + O_VI + (32 * wd + 8 * g + q4) * RSV + (16 * we + 4 * p4) * 2;
    u32x4 pq[NQC], pk_[NQC], pv; float pdt = 0.f;
#define SCAN_ISSUE(sidx) do { const size_t rbi = (size_t)it.rowbase + 64 * (sidx); \
        const GAS char* qb_ = (const GAS char*)(it.qg + rbi * it.ldq); const GAS char* kb_ = (const GAS char*)(it.kg + rbi * it.ldq); \
        _Pragma("unroll") for (int r = 0; r < NQC; ++r) { \
            pq[r] = *(const GAS u32x4*)(qb_ + (size_t)r * (512 / CPR) * it.ldq * 2 + voq); pk_[r] = *(const GAS u32x4*)(kb_ + (size_t)r * (512 / CPR) * it.ldq * 2 + voq); } \
        pv = *(const GAS u32x4*)((const GAS char*)(it.vg + rbi * it.ldv) + vov); \
        if (MODE) pdt = it.dtg[(rbi + lane) * 64]; } while (0)
    SCAN_ISSUE(0);
    for (int s = 0; s < it.nsteps; ++s) {
        const size_t rb = (size_t)it.rowbase + 64 * s; const int par = s & 1;
        float dtv = 0.f, cum = 0.f, cum63 = 0.f;
        if (MODE) { dtv = pdt; cum = dtv * it.Ah;
            cum = wave_scan_incl(cum);
            cum63 = __builtin_bit_cast(float, __builtin_amdgcn_readlane(__builtin_bit_cast(int, cum), 63));
            if (w == 0) { dcL[lane] = cum; dcL[64 + lane] = dtv; } }
        const size_t rbn = (size_t)it.rowbase + 64 * ((s + 1 < it.nsteps) ? s + 1 : s);
        { const GAS char* qn_ = (const GAS char*)(it.qg + rbn * it.ldq); const GAS char* kn_ = (const GAS char*)(it.kg + rbn * it.ldq);
#pragma unroll
          for (int r = 0; r < NQC; ++r) {
            *(LAS u32x2*)(lds + O_QI + r * (512 / CPR) * RSQ + lq) = (u32x2){pq[r].x, pq[r].y}; *(LAS u32x2*)(lds + O_QI + r * (512 / CPR) * RSQ + lq + 16) = (u32x2){pq[r].z, pq[r].w};
            pq[r] = *(const GAS u32x4*)(qn_ + (size_t)r * (512 / CPR) * it.ldq * 2 + voq);
            *(LAS u32x2*)(lds + O_KI + r * (512 / CPR) * RSQ + lq) = (u32x2){pk_[r].x, pk_[r].y}; *(LAS u32x2*)(lds + O_KI + r * (512 / CPR) * RSQ + lq + 16) = (u32x2){pk_[r].z, pk_[r].w};
            pk_[r] = *(const GAS u32x4*)(kn_ + (size_t)r * (512 / CPR) * it.ldq * 2 + voq);
            __builtin_amdgcn_sched_barrier(0); } }
        { const int j = tid >> 3; float cd;
          if (MODE) cd = __shfl(dtv * fast_exp(cum63 - cum), j & 63); else cd = __builtin_amdgcn_exp2f(it.lg2 * (float)(63 - j));
          *(LAS u32x4*)(lds + O_VI + lv) = pv;
          u32x4 sv; sv.x = cvt_pk_bf16(bf_lo(pv.x) * cd, bf_hi(pv.x) * cd); sv.y = cvt_pk_bf16(bf_lo(pv.y) * cd, bf_hi(pv.y) * cd);
          sv.z = cvt_pk_bf16(bf_lo(pv.z) * cd, bf_hi(pv.z) * cd); sv.w = cvt_pk_bf16(bf_lo(pv.w) * cd, bf_hi(pv.w) * cd);
          *(LAS u32x4*)(lds + O_VS + lv) = sv;
          pv = *(const GAS u32x4*)((const GAS char*)(it.vg + rbn * it.ldv) + vov);
          if (MODE) pdt = it.dtg[(rbn + lane) * 64]; }
        u32x2 pg0, pg1;
        { const GAS char* gb_ = (const GAS char*)(it.gg + rb * it.ldg); pg0 = *(const GAS u32x2*)(gb_ + vog); pg1 = *(const GAS u32x2*)(gb_ + (size_t)16 * it.ldg * 2 + vog); }
        __syncthreads();
        if (w == 0 && s > 0) { const float v = ssqL[(par ^ 1) * 64 + lane]; ssqL[(par ^ 1) * 64 + lane] = 0.f;
            (void)__hip_atomic_fetch_add(it.ssqg + (rb - 64 + lane) * 8 + it.ssq_col, v, __ATOMIC_RELAXED, __HIP_MEMORY_SCOPE_AGENT); }
        { const int jb = w & 3;
          f32x4 a2[2] = {(f32x4){0.f, 0.f, 0.f, 0.f}, (f32x4){0.f, 0.f, 0.f, 0.f}};
#pragma unroll
          for (int kk = 0; kk < NK1; ++kk) { const bf16x8 ka = *(const LAS bf16x8*)(lds + O_KI + (16 * jb + fr) * RSQ + (32 * kk + 8 * g) * 2);
#pragma unroll
              for (int ibi = 0; ibi < 2; ++ibi) { const bf16x8 qb = *(const LAS bf16x8*)(lds + O_QI + (16 * ((w >> 2) * 2 + ibi) + fr) * RSQ + (32 * kk + 8 * g) * 2);
                  a2[ibi] = __builtin_amdgcn_mfma_f32_16x16x32_bf16(ka, qb, a2[ibi], 0, 0, 0); } }
#pragma unroll
          for (int ibi = 0; ibi < 2; ++ibi) { const int ib = (w >> 2) * 2 + ibi; f32x4 a = a2[ibi];
            const int i = 16 * ib + fr, j0 = 16 * jb + 4 * g;
            if (MODE) { const float ci = dcL[i]; const f32x4 cj4 = *(const LAS f32x4*)(dcL + j0), dj4 = *(const LAS f32x4*)(dcL + 64 + j0);
#pragma unroll
                for (int r = 0; r < 4; ++r) { a[r] = (j0 + r <= i) ? a[r] * fast_exp(ci - cj4[r]) * dj4[r] : 0.f; } }
            else {
#pragma unroll
                for (int r = 0; r < 4; ++r) { const int df = i - (j0 + r); a[r] *= __builtin_amdgcn_exp2f(it.lg2 * (float)(df < 0 ? -df : df)); } }
            u32x2 pk; pk.x = cvt_pk_bf16(a[0], a[1]); pk.y = cvt_pk_bf16(a[2], a[3]);
            *(LAS u32x2*)(lds + O_PI + i * RSV + j0 * 2) = pk; } }
        __syncthreads();
        f32x4 O[4];
#pragma unroll
        for (int t = 0; t < 4; ++t) O[t] = (f32x4){0.f, 0.f, 0.f, 0.f};
#pragma unroll
        for (int kk = 0; kk < NK3; ++kk) {
            u32x4 sp; sp.x = cvt_pk_bf16(S[2 * kk][0], S[2 * kk][1]); sp.y = cvt_pk_bf16(S[2 * kk][2], S[2 * kk][3]); sp.z = cvt_pk_bf16(S[2 * kk + 1][0], S[2 * kk + 1][1]); sp.w = cvt_pk_bf16(S[2 * kk + 1][2], S[2 * kk + 1][3]);
            const bf16x8 sa = __builtin_bit_cast(bf16x8, sp);
#pragma unroll
            for (int t = 0; t < 4; ++t) { const bf16x8 qb = *(const LAS bf16x8*)(lds + O_QI + (16 * t + fr) * RSQ + (wd * DH + 32 * kk + 8 * g) * 2);
                O[t] = __builtin_amdgcn_mfma_f32_16x16x32_bf16(sa, qb, O[t], 0, 0, 0); } }
#pragma unroll
        for (int t = 0; t < 4; ++t) { const int i = 16 * t + fr; float rd;
            if (MODE) rd = fast_exp(dcL[i]); else rd = __builtin_amdgcn_exp2f(it.lg2 * (float)(i + 1));
            O[t] = O[t] * rd; }
        { const bf16x8 vt = tr_frag_i<0, 4 * RSV>(vibase);
#pragma unroll
          for (int t = 0; t < 4; ++t) { const bf16x8 pb = *(const LAS bf16x8*)(lds + O_PI + (16 * t + fr) * RSV + (32 * wd + 8 * g) * 2);
              O[t] = __builtin_amdgcn_mfma_f32_16x16x32_bf16(vt, pb, O[t], 0, 0, 0); } }
        f32x4 m0, m1;
        { const f32x4 x0 = wd ? O[0] : O[2], x1 = wd ? O[1] : O[3]; m0 = wd ? O[2] : O[0]; m1 = wd ? O[3] : O[1];
          *(LAS f32x4*)(lds + O_XC + ((w * 2 + 0) * 64 + lane) * 16) = x0;
          *(LAS f32x4*)(lds + O_XC + ((w * 2 + 1) * 64 + lane) * 16) = x1; }
        { const float cf = MODE ? fast_exp(cum63) : __builtin_amdgcn_exp2f(it.lg2 * 64.0f);
#pragma unroll
          for (int dt = 0; dt < NDT; ++dt) S[dt] = S[dt] * cf;
#define S4_QUAD(d0, kk) { constexpr int B_ = 32 * (kk) * RSQ + 32 * (d0);   \
              const bf16x8 k0_ = tr_frag_i<B_, B_ + 4 * RSQ>(kbase), k1_ = tr_frag_i<B_ + 8, B_ + 8 + 4 * RSQ>(kbase), k2_ = tr_frag_i<B_ + 64, B_ + 64 + 4 * RSQ>(kbase), k3_ = tr_frag_i<B_ + 72, B_ + 72 + 4 * RSQ>(kbase); \
              S[(d0) + 0] = __builtin_amdgcn_mfma_f32_16x16x32_bf16(k0_, vs, S[(d0) + 0], 0, 0, 0); S[(d0) + 1] = __builtin_amdgcn_mfma_f32_16x16x32_bf16(k1_, vs, S[(d0) + 1], 0, 0, 0); \
              S[(d0) + 2] = __builtin_amdgcn_mfma_f32_16x16x32_bf16(k2_, vs, S[(d0) + 2], 0, 0, 0); S[(d0) + 3] = __builtin_amdgcn_mfma_f32_16x16x32_bf16(k3_, vs, S[(d0) + 3], 0, 0, 0); }
#define S4_STEP(kk) { const bf16x8 vs = tr_frag_i<32 * (kk) * RSV, (32 * (kk) + 4) * RSV>(vsbase); S4_QUAD(0, kk) \
              if constexpr (NDT == 8) { S4_QUAD(4, kk) } }
          S4_STEP(0) S4_STEP(1)
#undef S4_STEP
#undef S4_QUAD
        }
        u32x2 xpre0 = {0u, 0u}, xpre1 = {0u, 0u};
        if (MODE) { xpre0 = *(const LAS u32x2*)(lds + O_VI + (16 * (2 * wd) + fr) * RSV + (16 * we + 4 * g) * 2); xpre1 = *(const LAS u32x2*)(lds + O_VI + (16 * (2 * wd + 1) + fr) * RSV + (16 * we + 4 * g) * 2); }
        __syncthreads();
#pragma unroll
        for (int t = 0; t < 2; ++t) {
            const f32x4 xin = *(const LAS f32x4*)(lds + O_XC + (((w ^ 4) * 2 + t) * 64 + lane) * 16);
            f32x4 o = (t ? m1 : m0) + xin; const int i = 16 * (2 * wd + t) + fr, e0 = 16 * we + 4 * g;
            const u32x2 pgt = t ? pg1 : pg0;
            const f32x4 gv = (f32x4){bf_lo(pgt.x), bf_hi(pgt.x), bf_lo(pgt.y), bf_hi(pgt.y)};
            float sq;
            if (MODE) { const u32x2 xw = t ? xpre1 : xpre0;
                const f32x4 xs = (f32x4){bf_lo(xw.x), bf_hi(xw.x), bf_lo(xw.y), bf_hi(xw.y)};
                o = (o + xs * it.Dh) * gv; sq = (o[0] * o[0] + o[1] * o[1]) + (o[2] * o[2] + o[3] * o[3]); }
            else { sq = (o[0] * o[0] + o[1] * o[1]) + (o[2] * o[2] + o[3] * o[3]); o = o * gv; }
            u32x2 pk; pk.x = cvt_pk_bf16(o[0], o[1]); pk.y = cvt_pk_bf16(o[2], o[3]);
            *(GAS u32x2*)((GAS char*)(it.yg + rb * it.ldg) + (size_t)t * 16 * it.ldg * 2 + vog) = pk;
            sq = rows_sum4(sq);
            if (g == 0) __hip_atomic_fetch_add(ssqL + par * 64 + i, sq, __ATOMIC_RELAXED, __HIP_MEMORY_SCOPE_WORKGROUP);
        }
    }
    __syncthreads();
    if (w == 0) { const int pl = (it.nsteps - 1) & 1; const float v = ssqL[pl * 64 + lane]; ssqL[pl * 64 + lane] = 0.f;
        (void)__hip_atomic_fetch_add(it.ssqg + ((size_t)it.rowbase + 64 * (it.nsteps - 1) + lane) * 8 + it.ssq_col, v, __ATOMIC_RELAXED, __HIP_MEMORY_SCOPE_AGENT); }
#undef SCAN_ISSUE
#pragma unroll
    for (int dt = 0; dt < NDT; ++dt)
#pragma unroll
        for (int r = 0; r < 4; ++r) { const int d = wd * DH + 16 * dt + 4 * g + r, e = 16 * we + fr; it.s_out[(size_t)d * it.sd + (size_t)e * it.se] = S[dt][r]; }
    __syncthreads();
}

#define XB_TMO      128
#define XB_XCNT(j)  (256  + 64 * (j))
#define XB_XSUB(j)  (1280 + 64 * (j))
#define XB_XGEN(j)  (2304 + 64 * (j))
#define XB_TOP      3328
#define XB_TOPGEN   3392
#define XCD_BAR_WORDS 3456
#define XB_SPIN_CAP (1u << 22)
__device__ __forceinline__ unsigned xb_ld(unsigned* p)              { return __hip_atomic_load(p, __ATOMIC_RELAXED, __HIP_MEMORY_SCOPE_AGENT); }
__device__ __forceinline__ unsigned xb_add(unsigned* p, unsigned v) { return __hip_atomic_fetch_add(p, v, __ATOMIC_RELAXED, __HIP_MEMORY_SCOPE_AGENT); }
__device__ __forceinline__ unsigned xb_xcc_id() { return (unsigned)__builtin_amdgcn_s_getreg((3 << 11) | 20) & 0xFu; }
#define XB_SPIN(cond, bar) do { unsigned _sp = 0; while (cond) { __builtin_amdgcn_s_sleep(1); \
    if ((++_sp & 255u) == 0u) { if (xb_ld(&(bar)[XB_TMO])) break; if (_sp > XB_SPIN_CAP) { atomicAdd(&(bar)[XB_TMO], 1u); break; } } } } while (0)
struct XcdBarrier { unsigned* bar; unsigned x; volatile LAS unsigned* st; };
__device__ __forceinline__ XcdBarrier xcd_barrier_post(unsigned* bar, volatile LAS unsigned* st, const int wv) {
    XcdBarrier b; b.bar = bar; b.x = xb_xcc_id(); b.st = st;
    if (fresh_tid(wv) == 0) (void)xb_add(&bar[XB_XCNT(b.x)], 1u);
    return b;
}
__device__ __forceinline__ void xcd_barrier_complete(unsigned* bar, unsigned x, unsigned& nloc, unsigned& nx) {
    const unsigned G = gridDim.x * gridDim.y * gridDim.z;
    unsigned sum, cnt, mine, sp = 0u;
    for (;;) {
        sum = 0u; cnt = 0u; mine = 0u;
#pragma unroll
        for (unsigned j = 0; j < 16; ++j) { const unsigned c = xb_ld(&bar[XB_XCNT(j)]); sum += c; cnt += (c > 0u) ? 1u : 0u; mine = (j == x) ? c : mine; }
        if (sum == G) break;
        __builtin_amdgcn_s_sleep(1);
        if ((++sp & 255u) == 0u) { if (xb_ld(&bar[XB_TMO])) break; if (sp > XB_SPIN_CAP) { atomicAdd(&bar[XB_TMO], 1u); break; } }
    }
    nloc = mine > 0u ? mine : 1u; nx = cnt > 0u ? cnt : 1u;
}
__device__ __forceinline__ void xcd_barrier(const XcdBarrier& b, const int wv) {
    asm volatile("s_waitcnt vmcnt(0)" ::: "memory");
    __syncthreads();
    if (fresh_tid(wv) == 0) {
        unsigned* bar = b.bar;
        __builtin_amdgcn_s_waitcnt(0);
        unsigned nloc = b.st[0], nx = b.st[1];
        if (nloc == 0u) { xcd_barrier_complete(bar, b.x, nloc, nx); b.st[0] = nloc; b.st[1] = nx; }
        const unsigned old = xb_add(&bar[XB_XSUB(b.x)], 1u);
        const unsigned gen = old / nloc;
        if (old + 1u == (gen + 1u) * nloc) {
            __builtin_amdgcn_fence(__ATOMIC_RELEASE, "agent");
            asm volatile("s_waitcnt vmcnt(0)" ::: "memory");
            const unsigned og = xb_add(&bar[XB_TOP], 1u);
            const unsigned tg = og / nx;
            if (og + 1u == (tg + 1u) * nx) xb_add(&bar[XB_TOPGEN], 1u);
            else XB_SPIN(xb_ld(&bar[XB_TOPGEN]) == tg, bar);
            __builtin_amdgcn_fence(__ATOMIC_ACQUIRE, "agent");
            xb_add(&bar[XB_XGEN(b.x)], 1u);
            asm volatile("s_waitcnt vmcnt(0)" ::: "memory");
        } else {
            XB_SPIN(xb_ld(&bar[XB_XGEN(b.x)]) == gen, bar);
            __builtin_amdgcn_fence(__ATOMIC_ACQUIRE, "agent");
            asm volatile("s_waitcnt vmcnt(0)" ::: "memory");
        }
    }
    __syncthreads();
}

__device__ __forceinline__ void wt_item(const GAS float* W, int K, int N, GAS bf16* Wt, const GAS float* lnw, int mode, LAS float* scr, int item, int lane) {
    const int nblk = N >> 6, kb = item / nblk, nb = item - kb * nblk, k0 = kb << 6, n0 = nb << 6;
    { f32x4 v[16]; float lw[16];
      const int c = 4 * (lane & 15); const GAS float* wp = W + (size_t)(k0 + (lane >> 4)) * N + n0 + c;
#pragma unroll
      for (int i = 0; i < 16; ++i) { v[i] = *(const GAS f32x4*)(wp + (size_t)(4 * i) * N); lw[i] = lnw ? lnw[k0 + (lane >> 4) + 4 * i] : 1.0f; }
#pragma unroll
      for (int i = 0; i < 16; ++i) { const int kk = (lane >> 4) + 4 * i; const f32x4 t = v[i] * lw[i];
        scr[kk * 65 + c] = t[0]; scr[kk * 65 + c + 1] = t[1]; scr[kk * 65 + c + 2] = t[2]; scr[kk * 65 + c + 3] = t[3]; } }
    LDS_WAIT(); asm volatile("" ::: "memory");
    const int c8 = lane & 7;
#pragma unroll
    for (int i = 0; i < 8; ++i) { const int n = (lane >> 3) + 8 * i; const LAS float* s = scr + (8 * c8) * 65 + n;
        u32x4 o; o.x = cvt_pk_bf16(s[0], s[65]); o.y = cvt_pk_bf16(s[130], s[195]); o.z = cvt_pk_bf16(s[260], s[325]); o.w = cvt_pk_bf16(s[390], s[455]);
        const int nn = n0 + n; const int drow = mode == 0 ? nn : (256 * (nn >> 7) + (nn & 127) + (mode == 2 ? 128 : 0));
        *(GAS u32x4*)(Wt + (size_t)drow * (K + WPAD) + k0 + 8 * c8) = o; }
    LDS_WAIT(); asm volatile("" ::: "memory");
}

#define INP(k) ((const GAS float*)args.in[k])
struct Args {
    const float* in[21]; float* out; unsigned char* ws;
    int ph_lo, ph_hi;
    float lg2[8];
    float pad0, pad1;
    double invrev[128];
};

__global__ void __launch_bounds__(NWAVES * 64, 2) mega_fwd(Args args) {
    extern __shared__ __attribute__((aligned(16))) unsigned char lds_raw[];
    LAS unsigned char* lds = (LAS unsigned char*)lds_raw;
    volatile LAS unsigned* MISC = (volatile LAS unsigned*)(lds + MISC_OFF);
    const int wv = __builtin_amdgcn_readfirstlane(threadIdx.x >> 6);
    const int G = gridDim.x, bx = blockIdx.x, vcu = (G % 8 == 0) ? (bx % 8) * (G / 8) + bx / 8 : bx;
    gu32* ctl = (gu32*)(args.ws + WS_CTL);
    for (int u = fresh_tid(wv); u < (LDS_BYTES - MISC_OFF) / 4; u += NWAVES * 64) ((LAS unsigned*)(lds + MISC_OFF))[u] = 0u;
    __syncthreads();
    if (!MK_PER_PHASE) (void)xcd_barrier_post((unsigned*)ctl + 4096, MISC + 8, wv);
    const int lo = args.ph_lo, hi = args.ph_hi;
#ifndef PH_MASK
#define PH_MASK 0x1fff
#endif
#define IN(k) (((PH_MASK >> (k)) & 1) && lo <= (k) && (k) < hi)
#define SEAM(k) do { if (!MK_PER_PHASE && IN(k) && IN((k) + 1)) { XcdBarrier b_; b_.bar = (unsigned*)(args.ws + WS_CTL) + 4096; b_.x = xb_xcc_id(); b_.st = (volatile LAS unsigned*)(lds + MISC_OFF) + 8; xcd_barrier(b_, wv); } } while (0)
    const int NGW = G * NWAVES;
#define SEAM_COUNT(cntp) do { gu32* cp_ = (cntp); asm volatile("s_waitcnt vmcnt(0)" ::: "memory"); __syncthreads(); \
        if (fresh_tid(wv) == 0) { if (bx < G - 16) { __builtin_amdgcn_fence(__ATOMIC_RELEASE, "agent"); asm volatile("s_waitcnt vmcnt(0)" ::: "memory"); (void)__hip_atomic_fetch_add(cp_, 8u, __ATOMIC_RELAXED, __HIP_MEMORY_SCOPE_AGENT); } \
            pg8::wait_count(cp_, (unsigned)G * 8u); asm volatile("s_waitcnt vmcnt(0)" ::: "memory"); } \
        __syncthreads(); } while (0)
#define PHASE_IDS() const int tid = fresh_tid(wv), lane = tid & 63, wave = wv, gw = vcu * NWAVES + wave; (void)lane; (void)gw
#define PHASE_PTRS() GAS unsigned char* ws = (GAS unsigned char*)args.ws; GAS float* out = (GAS float*)args.out; asm volatile("" : "+s"(ws), "+s"(out)); (void)out; \
    GAS float* X = (GAS float*)(ws + WS_X); GAS bf16* XB = (GAS bf16*)(ws + WS_XB); GAS float* SSQ = (GAS float*)(ws + OFF_SSQ); GAS float* SSQR = (GAS float*)(ws + OFF_SSQR); GAS float* SSQS = (GAS float*)(ws + OFF_SSQS); \
    GAS float* COS = (GAS float*)(ws + WS_COS); GAS float* SIN = (GAS float*)(ws + WS_SIN); GAS float* DT = (GAS float*)(ws + WS_DT); (void)X; (void)XB; (void)SSQ; (void)SSQR; (void)SSQS; (void)COS; (void)SIN; (void)DT

#define WJOB(Wp, Kk, Nn, dstoff, lnwp, md) do { const int nitems = ((Kk) >> 6) * ((Nn) >> 6); int first = cw - (base % CNW); if (first < 0) first += CNW; \
        for (int itx = first; itx < nitems; itx += CNW) wt_item((Wp), (Kk), (Nn), (GAS bf16*)(ws + (dstoff)), (lnwp), (md), scr, itx, lane); base += nitems; } while (0)
#define CONV_RET() do { WJOB(INP(8), DM, RET_IN, W_RIN, INP(5), 0); WJOB(INP(9), VDIM, DM, W_ROUT, (const GAS float*)nullptr, 0); } while (0)
#define CONV_FFN0() do { WJOB(INP(18), DM, FF, W_F0GU, INP(6), 1); WJOB(INP(19), DM, FF, W_F0GU, INP(6), 2); WJOB(INP(20), FF, DM, W_F0D, (const GAS float*)nullptr, 0); } while (0)
#define CONV_L1A() do { WJOB(INP(10), DM, SSD_IN, W_SIN, INP(5) + DM, 0); \
        { GAS u32x4* p = (GAS u32x4*)(ws + W_SIN + (size_t)SSD_IN * (DM + WPAD) * 2); const int n16 = (SSD_INP - SSD_IN) * (DM + WPAD) * 2 / 16; \
          for (int i = cw * 64 + lane; i < n16; i += CNW * 64) p[i] = (u32x4){0u, 0u, 0u, 0u}; } } while (0)
#define CONV_L1B() do { WJOB(INP(17), VDIM, DM, W_SOUT, INP(16), 0); \
        WJOB(INP(18) + (size_t)DM * FF, DM, FF, W_F1GU, INP(6) + DM, 1); WJOB(INP(19) + (size_t)DM * FF, DM, FF, W_F1GU, INP(6) + DM, 2); WJOB(INP(20) + (size_t)FF * DM, FF, DM, W_F1D, (const GAS float*)nullptr, 0); } while (0)
    if (IN(0)) {
        PHASE_PTRS();
        PHASE_IDS();
        LAS float* scr = (LAS float*)(lds + wave * 16640);
        { const int cw = gw, CNW = NGW; int base = 0; CONV_RET(); (void)base; }
        {
            f32x4 vn[8]; int m = gw;
            if (m < MROWS) { const GAS float* xr = m < MP ? INP(0) + (size_t)m * DM : INP(1) + (size_t)(m - MP) * DM;
#pragma unroll
                for (int j = 0; j < 8; ++j) vn[j] = *(const GAS f32x4*)(xr + 256 * j + 4 * lane); }
            for (; m < MROWS; m += NGW) {
                f32x4 vc[8];
#pragma unroll
                for (int j = 0; j < 8; ++j) vc[j] = vn[j];
                const int m2 = m + NGW;
                if (m2 < MROWS) { const GAS float* xr = m2 < MP ? INP(0) + (size_t)m2 * DM : INP(1) + (size_t)(m2 - MP) * DM;
#pragma unroll
                    for (int j = 0; j < 8; ++j) vn[j] = *(const GAS f32x4*)(xr + 256 * j + 4 * lane); }
                float s = 0.f;
#pragma unroll
                for (int j = 0; j < 8; ++j) { const f32x4 v = vc[j];
                    u32x2 pw; pw.x = cvt_pk_bf16(v[0], v[1]); pw.y = cvt_pk_bf16(v[2], v[3]);
                    *(GAS u32x2*)(XB + (size_t)m * DM + 256 * j + 4 * lane) = pw; s += (v[0] * v[0] + v[1] * v[1]) + (v[2] * v[2] + v[3] * v[3]); }
                s = wave_sum(s); if (lane == 0) SSQ[m] = s;
            }
        }
        __syncthreads();
    }
    SEAM(0);

    if (IN(1)) {
        PHASE_PTRS();
        pg8::Gemm g{XB, (const GAS bf16*)(ws + W_RIN), MROWS, RET_IN, DM}; pg8::RetOrder S; S.init(32 * 256, RET_IN, G, bx);
        EpiRetIn E{(LAS float*)(lds + pg8::STAGE_BYTES + 4096), (GAS bf16*)(ws + SC_Q), (GAS bf16*)(ws + SC_K), (GAS bf16*)(ws + SC_V), (GAS bf16*)(ws + SC_G), SSQ, (const GAS double*)args.invrev};
        pg8::gemm_phase<EpiRetIn, pg8::RetOrder>(lds, g, S, E, wv);
    }
    SEAM(1);

    if (IN(2)) {
        PHASE_PTRS();
        for (int c = vcu; c < 768; c += G) {
            ScanItem it; const bool smp = c >= 256; const int cc = smp ? c - 256 : c; const int b = cc >> 6, h = (cc >> 3) & 7, sl = cc & 7;
            it.qg = (const GAS bf16*)(ws + SC_Q) + h * 256; it.kg = (const GAS bf16*)(ws + SC_K) + h * 256; it.vg = (const GAS bf16*)(ws + SC_V) + h * 512 + sl * 64; it.ldq = DM; it.ldv = VDIM;
            it.gg = (const GAS bf16*)(ws + SC_G) + h * 512 + sl * 64; it.yg = (GAS bf16*)(ws + SC_V) + h * 512 + sl * 64; it.ldg = VDIM;
            it.ssqg = SSQR; it.ssq_col = h; it.rowbase = smp ? MP + b * 64 : b * 2048; it.nsteps = smp ? 1 : 32;
            const size_t so = ((size_t)(b * 8 + h) * 256) * 512 + sl * 64;
            it.s_in = smp ? INP(2) + so : nullptr; it.s_out = out + (smp ? OUT_RETS : OUT_RETP) + so; it.sd = 512; it.se = 1;
            it.lg2 = args.lg2[h]; it.dtg = nullptr; it.Ah = 0.f; it.Dh = 0.f;
            scan_chain<0>(lds, it, wv);
        }
    }
    SEAM(2);

    if (IN(3)) {
        PHASE_PTRS();
        pg8::Gemm g{(const GAS bf16*)(ws + SC_V), (const GAS bf16*)(ws + W_ROUT), MROWS, DM, VDIM}; pg8::StaticOrder S; S.init(32 * 256, DM, G, bx);
        EpiResid<true, true> E{XB, SSQ + 1 * MROWS, SSQR, nullptr, nullptr};
        pg8::gemm_phase<EpiResid<true, true>, pg8::StaticOrder>(lds, g, S, E, wv);
        { PHASE_IDS(); LAS float* scr = (LAS float*)(lds + wave * 16640); const int cw = gw, CNW = NGW; int base = 0; CONV_FFN0(); (void)base; __syncthreads(); }
    }
    SEAM(3);
    if (IN(4)) {
        PHASE_PTRS();
        pg8::Gemm g{XB, (const GAS bf16*)(ws + W_F0GU), MROWS, FF2, DM}; pg8::StaticOrder S; S.init(MROWS, FF2, G, bx);
        EpiFfnGU E{(GAS bf16*)(ws + SC_H), SSQ + 1 * MROWS};
        pg8::gemm_phase<EpiFfnGU, pg8::StaticOrder>(lds, g, S, E, wv);
    }
    SEAM(4);
    if (IN(5)) {
        PHASE_PTRS();
        pg8::Gemm g{(const GAS bf16*)(ws + SC_H), (const GAS bf16*)(ws + W_F0D), MROWS, DM, FF}; pg8::StaticOrder S; S.init(32 * 256, DM, G, bx);
        EpiResid<false, true> E{XB, SSQ + 2 * MROWS, nullptr, nullptr, nullptr};
        pg8::gemm_phase<EpiResid<false, true>, pg8::StaticOrder>(lds, g, S, E, wv);
        { PHASE_IDS(); LAS float* scr = (LAS float*)(lds + wave * 16640); const int cw = gw, CNW = NGW; int base = 0; CONV_L1A(); if (G != 256) CONV_L1B(); (void)base; __syncthreads(); }
    }
    SEAM(5);
    if (IN(6)) {
        PHASE_PTRS();
        const int NG6 = (G == 256) ? 233 : G;
        if (bx < NG6) {
            pg8::Gemm g{XB, (const GAS bf16*)(ws + W_SIN), MROWS, SSD_INP, DM}; pg8::StaticOrder S; S.init(MROWS, SSD_INP, NG6, bx);
            EpiSsdIn E{(GAS bf16*)(ws + SC_Z), (GAS bf16*)(ws + SC_XBC), DT, SSQ + 2 * MROWS, INP(13), out + OUT_CONVP, out + OUT_CONVS};
            pg8::gemm_phase<EpiSsdIn, pg8::StaticOrder>(lds, g, S, E, wv);
        } else { PHASE_IDS(); LAS float* scr = (LAS float*)(lds + wave * 16640); const int cw = (bx - NG6) * NWAVES + wave, CNW = (G - NG6) * NWAVES; int base = 0; CONV_L1B(); (void)base; __syncthreads(); }
    }
    SEAM(6);
    if (IN(7)) {
        PHASE_PTRS();
        PHASE_IDS();
        const GAS bf16* XBC = (const GAS bf16*)(ws + SC_XBC); GAS bf16* XC = (GAS bf16*)(ws + SC_XC);
        constexpr int RS = 64, NCH = CONVD / 8, NITEM = (MROWS / RS) * NCH;
        for (int item = (wave * G + vcu) * 64 + lane; item < NITEM; item += G * NWAVES * 64) {
            const int sg = item / NCH, c = (item - sg * NCH) * 8, r0 = sg * RS;
            f32x4 w[4][2], bs[2];
#pragma unroll
            for (int tau = 0; tau < 4; ++tau) { w[tau][0] = *(const GAS f32x4*)(INP(11) + tau * CONVD + c); w[tau][1] = *(const GAS f32x4*)(INP(11) + tau * CONVD + c + 4); }
            bs[0] = *(const GAS f32x4*)(INP(12) + c); bs[1] = *(const GAS f32x4*)(INP(12) + c + 4);
            const GAS bf16* src = XBC + (size_t)r0 * CONVD + c; GAS bf16* dst = XC + (size_t)r0 * CONVD + c;
            u32x4 xn[8];
#pragma unroll
            for (int i = 0; i < 8; ++i) xn[i] = *(const GAS u32x4*)(src + (size_t)i * CONVD);
            f32x4 h[3][2];
            const bool seq0 = r0 < MP ? (r0 & 2047) == 0 : ((r0 - MP) & 63) == 0;
            if (!seq0) {
#pragma unroll
                for (int k = 0; k < 3; ++k) { const u32x4 p = *(const GAS u32x4*)(src - (size_t)(3 - k) * CONVD);
                    h[k][0] = (f32x4){bf_lo(p.x), bf_hi(p.x), bf_lo(p.y), bf_hi(p.y)}; h[k][1] = (f32x4){bf_lo(p.z), bf_hi(p.z), bf_lo(p.w), bf_hi(p.w)}; }
            } else if (r0 >= MP) { const GAS float* c0p = INP(4) + (size_t)((r0 - MP) >> 6) * 3 * CONVD + c;
#pragma unroll
                for (int k = 0; k < 3; ++k) { h[k][0] = *(const GAS f32x4*)(c0p + (size_t)k * CONVD); h[k][1] = *(const GAS f32x4*)(c0p + (size_t)k * CONVD + 4); }
            } else {
#pragma unroll
                for (int k = 0; k < 3; ++k) { h[k][0] = (f32x4){0.f, 0.f, 0.f, 0.f}; h[k][1] = h[k][0]; }
            }
            for (int rb = 0; rb < RS; rb += 8) {
                u32x4 xc[8];
#pragma unroll
                for (int i = 0; i < 8; ++i) xc[i] = xn[i];
                if (rb + 8 < RS) {
#pragma unroll
                    for (int i = 0; i < 8; ++i) xn[i] = *(const GAS u32x4*)(src + (size_t)(rb + 8 + i) * CONVD);
                }
#pragma unroll
                for (int i = 0; i < 8; ++i) {
                    const f32x4 c0 = (f32x4){bf_lo(xc[i].x), bf_hi(xc[i].x), bf_lo(xc[i].y), bf_hi(xc[i].y)}, c1 = (f32x4){bf_lo(xc[i].z), bf_hi(xc[i].z), bf_lo(xc[i].w), bf_hi(xc[i].w)};
                    const f32x4 a0 = bs[0] + h[0][0] * w[0][0] + h[1][0] * w[1][0] + h[2][0] * w[2][0] + c0 * w[3][0];
                    const f32x4 a1 = bs[1] + h[0][1] * w[0][1] + h[1][1] * w[1][1] + h[2][1] * w[2][1] + c1 * w[3][1];
                    *(GAS u32x4*)(dst + (size_t)(rb + i) * CONVD) = pack8(silu4(a0), silu4(a1));
                    h[0][0] = h[1][0]; h[0][1] = h[1][1]; h[1][0] = h[2][0]; h[1][1] = h[2][1]; h[2][0] = c0; h[2][1] = c1;
                }
            }
        }
    }
    SEAM(7);
    if (IN(8)) {
        PHASE_PTRS();
        const GAS bf16* XC = (const GAS bf16*)(ws + SC_XC);
        for (int c = vcu; c < 768; c += G) {
            ScanItem it; const bool smp = c >= 256; const int cc = smp ? c - 256 : c; const int b = cc >> 6, head = cc & 63, grp = head >> 3;
            it.qg = XC + 5120 + grp * 128; it.kg = XC + 4096 + grp * 128; it.vg = XC + head * 64; it.ldq = CONVD; it.ldv = CONVD;
            it.gg = (const GAS bf16*)(ws + SC_Z) + head * 64; it.yg = (GAS bf16*)(ws + SC_Z) + head * 64; it.ldg = VDIM;
            it.ssqg = SSQS; it.ssq_col = grp; it.rowbase = smp ? MP + b * 64 : b * 2048; it.nsteps = smp ? 1 : 32;
            const size_t so = (size_t)(b * 64 + head) * 64 * 128;
            it.s_in = smp ? INP(3) + so : nullptr; it.s_out = out + (smp ? OUT_SSMS : OUT_SSMP) + so; it.sd = 1; it.se = 128;
            it.lg2 = 0.f; it.dtg = DT + head; it.Ah = -__expf(INP(14)[head]); it.Dh = INP(15)[head];
            scan_chain<1>(lds, it, wv);
        }
    }
    SEAM(8);
    if (IN(9)) {
        PHASE_PTRS();
        pg8::Gemm g{(const GAS bf16*)(ws + SC_Z), (const GAS bf16*)(ws + W_SOUT), MROWS, DM, VDIM}; pg8::StaticOrder S; S.init(32 * 256, DM, G, bx);
        EpiResid<true, true> E{XB, SSQ + 3 * MROWS, SSQS, nullptr, nullptr};
        pg8::gemm_phase<EpiResid<true, true>, pg8::StaticOrder>(lds, g, S, E, wv);
    }
    SEAM(9);
    if (IN(10)) {
        PHASE_PTRS();
        pg8::Gemm g{XB, (const GAS bf16*)(ws + W_F1GU), MROWS, FF2, DM}; pg8::StaticOrder S; S.init(MROWS, FF2, G, bx);
        EpiFfnGU E{(GAS bf16*)(ws + SC_H1), SSQ + 3 * MROWS};
        pg8::gemm_phase<EpiFfnGU, pg8::StaticOrder>(lds, g, S, E, wv);
    }
    SEAM(10);
    if (IN(11)) {
        PHASE_PTRS();
        pg8::Gemm g{(const GAS bf16*)(ws + SC_H1), (const GAS bf16*)(ws + W_F1D), MROWS, DM, FF}; pg8::StaticOrder S; S.init(32 * 256, DM, G, bx);
        if (G == 256 && !MK_PER_PHASE && IN(12)) {
            EpiFinal E{XB, SSQ + 4 * MROWS, INP(7), out + OUT_Y, (gu32*)(ws + SEAMCNT_OFF + 8192)};
            pg8::gemm_phase<EpiFinal, pg8::StaticOrder>(lds, g, S, E, wv);
        } else {
            EpiResid<false, true> E{XB, SSQ + 4 * MROWS, nullptr, nullptr, nullptr};
            pg8::gemm_phase<EpiResid<false, true>, pg8::StaticOrder>(lds, g, S, E, wv);
        }
    }
    if (!(G == 256 && !MK_PER_PHASE && IN(11) && IN(12))) {
    SEAM(11);
    if (IN(12)) {
        PHASE_PTRS();
        PHASE_IDS();
        for (int m = gw; m < MROWS; m += NGW) {
            const float rs = __builtin_amdgcn_rsqf(SSQ[4 * MROWS + m] * (1.0f / DM) + EPS);
#pragma unroll
            for (int j = 0; j < 8; ++j) { const u32x2 xw = *(const GAS u32x2*)(XB + (size_t)m * DM + 256 * j + 4 * lane); const f32x4 v = (f32x4){bf_lo(xw.x), bf_hi(xw.x), bf_lo(xw.y), bf_hi(xw.y)}, lw = *(const GAS f32x4*)(INP(7) + 256 * j + 4 * lane);
                *(GAS f32x4*)(out + OUT_Y + (size_t)m * DM + 256 * j + 4 * lane) = v * rs * lw; }
        }
    }
    }
#undef IN
#undef SEAM
}

extern "C" void kernel_launch(void* const* d_in, const int* in_sizes, int n_in, void* d_out, int out_size, void* d_ws, size_t ws_size, hipStream_t stream) {
    static int grid = 0;
    if (grid == 0) {
        if (n_in != 21 || out_size != (int)OUT_END || ws_size < WS_END) { fprintf(stderr, "kernel_launch: unexpected shapes (n_in %d out %d ws %zu, need ws >= %zu)\n", n_in, out_size, ws_size, (size_t)WS_END); grid = -1; return; }
        int dev = 0, cus = 0, per_cu = 0;
        if (hipGetDevice(&dev) != hipSuccess || hipDeviceGetAttribute(&cus, hipDeviceAttributeMultiprocessorCount, dev) != hipSuccess) { grid = -1; return; }
        if (hipFuncSetAttribute((const void*)mega_fwd, hipFuncAttributeMaxDynamicSharedMemorySize, LDS_BYTES) != hipSuccess) { fprintf(stderr, "kernel_launch: hipFuncSetAttribute failed\n"); grid = -1; return; }
        if (hipOccupancyMaxActiveBlocksPerMultiprocessor(&per_cu, (const void*)mega_fwd, NWAVES * 64, LDS_BYTES) != hipSuccess || per_cu < 1) { fprintf(stderr, "kernel_launch: occupancy query says %d blocks per CU\n", per_cu); per_cu = 1; }
        (void)hipGetLastError();
        grid = cus * (per_cu < 1 ? 1 : 1);
        if (grid % 8 != 0 || grid > 768) fprintf(stderr, "kernel_launch: note: grid %d\n", grid);
    }
    if (grid < 0) return;
    (void)hipMemsetAsync((char*)d_ws + WS_CTL, 0, CTL_BYTES, stream);
    Args a{};
    for (int i = 0; i < 21; ++i) a.in[i] = (const float*)d_in[i];
    a.out = (float*)d_out; a.ws = (unsigned char*)d_ws;
    for (int h = 0; h < 8; ++h) a.lg2[h] = (float)(log1p(-exp2(-5.0 - (double)h)) / log(2.0));
    for (int d = 0; d < 128; ++d) a.invrev[d] = pow(10000.0, -(double)d / 128.0) / (2.0 * M_PI);
#if MK_PER_PHASE
    for (int p = 0; p < 13; ++p) { a.ph_lo = p; a.ph_hi = p + 1; hipLaunchKernelGGL(mega_fwd, dim3(grid), dim3(NWAVES * 64), LDS_BYTES, stream, a); }
#else
    a.ph_lo = 0; a.ph_hi = 13;
    void* kargs[] = {&a};
    hipError_t e = hipLaunchCooperativeKernel((const void*)mega_fwd, dim3(grid), dim3(NWAVES * 64), kargs, LDS_BYTES, stream);
    if (e != hipSuccess) fprintf(stderr, "kernel_launch: cooperative launch failed: %s (grid %d)\n", hipGetErrorString(e), grid);
#endif
}
```
